# Optimizing an MI355X kernel written in HIP

```python
import jax, jax.numpy as jnp
from jax import lax
import numpy as np

D_MODEL = 2048
BATCH = 1
SEQ = 16384
DEPTH = 2

D_MIX = D_MODEL
SB_HEADS = 8
SB_HEAD_DIM = 128
SB_WIDTH = SB_HEADS * SB_HEAD_DIM
ML_HEADS = 4
ML_QK_DIM = 128
ML_V_DIM = 256
ML_QK_WIDTH = ML_HEADS * ML_QK_DIM
ML_V_WIDTH = ML_HEADS * ML_V_DIM
CONV_WIDTH = 4
ML_CHUNK = 64
Q_BLOCK = 128
D_FF = 5632
N_IN = 3 * SB_WIDTH + 2 * ML_QK_WIDTH + 2 * ML_V_WIDTH + 2 * ML_HEADS
N_SUB = 3
N_MOD = 3
ALPHA = (2 * DEPTH) ** 0.25
BETA = (8 * DEPTH) ** -0.25
LN_EPS = 1e-5

kernel_name = "hymba_style_stickbreak_mlstm_macaron_deepnorm_adaln"


def layer_norm(x, g, b):
    xf = x.astype(jnp.float32)
    mu = jnp.mean(xf, -1, keepdims=True)
    var = jnp.mean(jnp.square(xf - mu), -1, keepdims=True)
    return ((xf - mu) * lax.rsqrt(var + LN_EPS) * g + b).astype(x.dtype)


def head_norm(y, g):
    mu = jnp.mean(y, -1, keepdims=True)
    var = jnp.mean(jnp.square(y - mu), -1, keepdims=True)
    return (y - mu) * lax.rsqrt(var + LN_EPS) * g.reshape(y.shape[2:])


def swiglu_ffn(h, w1, w2):
    a, u = jnp.split(h @ w1, 2, axis=-1)
    return (jax.nn.silu(a) * u) @ w2


def causal_depthwise_conv(u, w, b):
    K = w.shape[0]
    S = u.shape[1]
    up = jnp.pad(u, ((0, 0), (K - 1, 0), (0, 0)))
    return b + sum(up[:, k:k + S, :] * w[k] for k in range(K))


def stick_breaking_attention(q, k, v):
    B, S, H, d = q.shape
    nb = S // Q_BLOCK
    qf = q.astype(jnp.float32) * (d ** -0.5)
    kf = k.astype(jnp.float32)
    vf = v.astype(jnp.float32)
    q_blocks = qf.reshape(B, nb, Q_BLOCK, H, d).transpose(1, 0, 3, 2, 4)
    key_pos = jnp.arange(S)

    def block(args):
        i, qb = args
        z = jnp.einsum('bhqd,bshd->bhqs', qb, kf)
        q_pos = i * Q_BLOCK + jnp.arange(Q_BLOCK)
        mask = key_pos[None, :] < q_pos[:, None]
        log_1mb = jnp.where(mask, jax.nn.log_sigmoid(-z), 0.0)
        log_stick = lax.cumsum(log_1mb, axis=log_1mb.ndim - 1, reverse=True) - log_1mb
        a = jnp.where(mask, jnp.exp(jax.nn.log_sigmoid(z) + log_stick), 0.0)
        return jnp.einsum('bhqs,bshd->bqhd', a, vf)

    out = lax.map(block, (jnp.arange(nb), q_blocks))
    return out.transpose(1, 0, 2, 3, 4).reshape(B, S, H, d)


def mlstm_chunkwise(q, k, v, log_i, log_f):
    B, S, H, dk = q.shape
    dv = v.shape[-1]
    L = ML_CHUNK
    nc = S // L

    def to_chunks(t):
        t = t.reshape((B, nc, L, H) + t.shape[3:])
        return jnp.moveaxis(t, (1, 3), (0, 2))

    causal = jnp.tril(jnp.ones((L, L), dtype=bool))

    def step(carry, xs):
        C, n, m = carry
        qc, kc, vc, ic, fc = xs
        b = jnp.cumsum(fc, axis=-1)
        log_d = jnp.where(causal, b[..., :, None] - b[..., None, :] + ic[..., None, :], -jnp.inf)
        log_g = b + m[..., None]
        m_t = jnp.maximum(jnp.max(log_d, -1), log_g)
        p = jnp.exp(log_d - m_t[..., None])
        g = jnp.exp(log_g - m_t)
        s = jnp.einsum('bhtd,bhsd->bhts', qc, kc) * p
        num = jnp.einsum('bhts,bhsv->bhtv', s, vc) + g[..., None] * jnp.einsum('bhtd,bhdv->bhtv', qc, C)
        den = jnp.sum(s, -1) + g * jnp.einsum('bhtd,bhd->bht', qc, n)
        h = num / jnp.maximum(jnp.abs(den), jnp.exp(-m_t))[..., None]
        b_last = b[..., -1]
        log_w = b_last[..., None] - b + ic
        m_new = jnp.maximum(b_last + m, jnp.max(log_w, -1))
        decay = jnp.exp(b_last + m - m_new)
        w = jnp.exp(log_w - m_new[..., None])
        C = decay[..., None, None] * C + jnp.einsum('bhs,bhsd,bhsv->bhdv', w, kc, vc)
        n = decay[..., None] * n + jnp.einsum('bhs,bhsd->bhd', w, kc)
        return (C, n, m_new), h

    init = (jnp.zeros((B, H, dk, dv), jnp.float32),
            jnp.zeros((B, H, dk), jnp.float32),
            jnp.zeros((B, H), jnp.float32))
    xs = (to_chunks(q), to_chunks(k), to_chunks(v), to_chunks(log_i), to_chunks(log_f))
    _, hs = lax.scan(step, init, xs)
    return jnp.moveaxis(hs, (0, 2), (1, 3)).reshape(B, S, H, dv)


def hybrid_mixer(h, w_in, conv_w, conv_b, gate_b, norm_g, w_out):
    B, S, _ = h.shape
    z = (h @ w_in).astype(jnp.float32)
    sizes = [SB_WIDTH, SB_WIDTH, SB_WIDTH, ML_QK_WIDTH, ML_QK_WIDTH,
             ML_V_WIDTH, ML_V_WIDTH, ML_HEADS, ML_HEADS]
    idx = np.cumsum(sizes)[:-1].tolist()
    q_sb, k_sb, v_sb, q_ml, k_ml, v_ml, o_ml, i_ml, f_ml = jnp.split(z, idx, axis=-1)

    y_sb = stick_breaking_attention(q_sb.reshape(B, S, SB_HEADS, SB_HEAD_DIM),
                                    k_sb.reshape(B, S, SB_HEADS, SB_HEAD_DIM),
                                    v_sb.reshape(B, S, SB_HEADS, SB_HEAD_DIM))
    y_sb = head_norm(y_sb, norm_g[:SB_WIDTH]).reshape(B, S, SB_WIDTH)

    qk = jax.nn.silu(causal_depthwise_conv(jnp.concatenate([q_ml, k_ml], -1), conv_w, conv_b))
    q_ml, k_ml = jnp.split(qk, 2, axis=-1)
    q_ml = q_ml * (ML_QK_DIM ** -0.5)
    log_i = i_ml + gate_b[:ML_HEADS]
    log_f = jax.nn.log_sigmoid(f_ml + gate_b[ML_HEADS:])
    y_ml = mlstm_chunkwise(q_ml.reshape(B, S, ML_HEADS, ML_QK_DIM),
                           k_ml.reshape(B, S, ML_HEADS, ML_QK_DIM),
                           v_ml.reshape(B, S, ML_HEADS, ML_V_DIM),
                           log_i, log_f)
    y_ml = jax.nn.sigmoid(o_ml) * head_norm(y_ml, norm_g[SB_WIDTH:]).reshape(B, S, ML_V_WIDTH)

    y = jnp.concatenate([y_sb, y_ml], axis=-1).astype(h.dtype)
    return y @ w_out


def setup_inputs(seed: int = 0) -> dict:
    key = jax.random.key(seed)
    ks = jax.random.split(key, 18)
    nrm = jax.random.normal
    f32 = jnp.float32
    x = nrm(ks[0], (BATCH, SEQ, D_MODEL), f32)
    c = nrm(ks[1], (BATCH, D_MODEL), f32)
    ada_w = nrm(ks[2], (DEPTH, D_MODEL, N_SUB * N_MOD * D_MODEL), f32) * (0.1 * D_MODEL ** -0.5)
    ada_b = nrm(ks[3], (DEPTH, N_SUB * N_MOD * D_MODEL), f32) * 0.01
    ln_g = 1.0 + 0.01 * nrm(ks[4], (DEPTH, N_SUB, D_MODEL), f32)
    ln_b = 0.01 * nrm(ks[5], (DEPTH, N_SUB, D_MODEL), f32)
    ffn1_w1 = nrm(ks[6], (DEPTH, D_MODEL, 2 * D_FF), f32) * D_MODEL ** -0.5
    ffn1_w2 = nrm(ks[7], (DEPTH, D_FF, D_MODEL), f32) * (BETA * D_FF ** -0.5)
    col_scale = jnp.concatenate([
        jnp.ones((2 * SB_WIDTH,), f32), jnp.full((SB_WIDTH,), BETA, f32),
        jnp.ones((2 * ML_QK_WIDTH,), f32), jnp.full((ML_V_WIDTH,), BETA, f32),
        jnp.ones((ML_V_WIDTH + 2 * ML_HEADS,), f32)])
    mix_w_in = nrm(ks[8], (DEPTH, D_MODEL, N_IN), f32) * (D_MODEL ** -0.5) * col_scale
    mlstm_conv_w = nrm(ks[9], (DEPTH, CONV_WIDTH, 2 * ML_QK_WIDTH), f32) * CONV_WIDTH ** -0.5
    mlstm_conv_b = 0.01 * nrm(ks[10], (DEPTH, 2 * ML_QK_WIDTH), f32)
    i_bias = 0.1 * nrm(ks[11], (DEPTH, ML_HEADS), f32)
    f_bias = jnp.linspace(3.0, 6.0, ML_HEADS, dtype=f32) + 0.1 * nrm(ks[12], (DEPTH, ML_HEADS), f32)
    mlstm_gate_b = jnp.concatenate([i_bias, f_bias], axis=-1)
    mix_norm_g = 1.0 + 0.01 * nrm(ks[13], (DEPTH, D_MIX), f32)
    mix_w_out = nrm(ks[14], (DEPTH, D_MIX, D_MODEL), f32) * (BETA * D_MIX ** -0.5)
    ffn2_w1 = nrm(ks[15], (DEPTH, D_MODEL, 2 * D_FF), f32) * D_MODEL ** -0.5
    ffn2_w2 = nrm(ks[16], (DEPTH, D_FF, D_MODEL), f32) * (BETA * D_FF ** -0.5)
    return {"x": x, "c": c, "ada_w": ada_w, "ada_b": ada_b, "ln_g": ln_g, "ln_b": ln_b,
            "ffn1_w1": ffn1_w1, "ffn1_w2": ffn1_w2, "mix_w_in": mix_w_in,
            "mlstm_conv_w": mlstm_conv_w, "mlstm_conv_b": mlstm_conv_b,
            "mlstm_gate_b": mlstm_gate_b, "mix_norm_g": mix_norm_g, "mix_w_out": mix_w_out,
            "ffn2_w1": ffn2_w1, "ffn2_w2": ffn2_w2}


def reference(x, c, ada_w, ada_b, ln_g, ln_b, ffn1_w1, ffn1_w2, mix_w_in,
              mlstm_conv_w, mlstm_conv_b, mlstm_gate_b, mix_norm_g, mix_w_out,
              ffn2_w1, ffn2_w2):
    B = x.shape[0]
    for l in range(DEPTH):
        mod = (jax.nn.silu(c) @ ada_w[l] + ada_b[l]).reshape(B, N_SUB, N_MOD, 1, D_MODEL)

        shift, scale, gate = mod[:, 0, 0], mod[:, 0, 1], mod[:, 0, 2]
        f = swiglu_ffn(x * (1 + scale) + shift, ffn1_w1[l], ffn1_w2[l])
        x = layer_norm(ALPHA * x + 0.5 * (1 + gate) * f, ln_g[l, 0], ln_b[l, 0])

        shift, scale, gate = mod[:, 1, 0], mod[:, 1, 1], mod[:, 1, 2]
        m = hybrid_mixer(x * (1 + scale) + shift, mix_w_in[l], mlstm_conv_w[l], mlstm_conv_b[l],
                         mlstm_gate_b[l], mix_norm_g[l], mix_w_out[l])
        x = layer_norm(ALPHA * x + (1 + gate) * m, ln_g[l, 1], ln_b[l, 1])

        shift, scale, gate = mod[:, 2, 0], mod[:, 2, 1], mod[:, 2, 2]
        f = swiglu_ffn(x * (1 + scale) + shift, ffn2_w1[l], ffn2_w2[l])
        x = layer_norm(ALPHA * x + 0.5 * (1 + gate) * f, ln_g[l, 2], ln_b[l, 2])
    return x
```

```cpp
#include <hip/hip_runtime.h>
#include <cstdio>
#include <cstdint>
namespace pg8 {
#define PG8_LAS __attribute__((address_space(3)))
typedef unsigned short bf16_t;
typedef short bf16x8 __attribute__((ext_vector_type(8)));
typedef float f32x4 __attribute__((ext_vector_type(4)));
typedef unsigned u32x4 __attribute__((ext_vector_type(4)));
constexpr int BM = 256, BK = 64, HALF = 128, HTB = HALF * BK * 2  , STAGE_BYTES = 8 * HTB, NXCD = 8, WGM = 8;

__host__ __device__ __forceinline__ int lds_byte(int r, int c) { const int st = (r >> 4) * 2 + (c >> 5), rr = r & 15, cc = c & 31, ob = rr * 64 + cc * 2; return st * 1024 + (ob ^ (((ob >> 9) & 1) << 5)); }
__host__ __device__ __forceinline__ void stage_rc(int b, int& R, int& C) { const int st = b / 1024, sb = b % 1024, swz = sb ^ (((sb >> 9) & 1) << 5); R = (st >> 1) * 16 + swz / 64; C = (st & 1) * 32 + (swz % 64) / 2; }
__host__ __device__ __forceinline__ int perm32(int rho) { const int n = rho >> 4, i = rho & 15; return 8 * (i >> 2) + 4 * n + (i & 3); }

struct Unit { int pm, pn; };
struct Gemm { const bf16_t* A; const bf16_t* Bt; int M, N, K; };

struct StaticOrder {
    int nM, nN, nwg, G, c;
    __host__ __device__ void init(int M, int N, int G_, int c_) { nM = M / BM; nN = N / BM; nwg = nM * nN; G = G_; c = c_; }
    __host__ __device__ bool next(int i, Unit& u) const {
        const long L = (long)i * G + c; if (L >= nwg) return false;
        int wgid = (int)L; { const int q = nwg / NXCD, r = nwg % NXCD, xcd = wgid % NXCD, off = wgid / NXCD; wgid = (xcd < r ? xcd * (q + 1) : r * (q + 1) + (xcd - r) * q) + off; }
        const int nig = WGM * nN, gid = wgid / nig, fm = gid * WGM, gsz = (nM - fm) < WGM ? (nM - fm) : WGM;
        u.pm = fm + ((wgid % nig) % gsz); u.pn = (wgid % nig) / gsz; return true;
    }
    __device__ __forceinline__ void a_ready(const Unit&) const {}
    __device__ __forceinline__ void done(const Unit&) const {}
};

__device__ __forceinline__ unsigned cvt_pk_bf16(float lo, float hi) { unsigned r; asm volatile("v_cvt_pk_bf16_f32 %0, %1, %2" : "=v"(r) : "v"(lo), "v"(hi)); return r; }
__device__ __forceinline__ float silu_f(float a) { return a * __builtin_amdgcn_rcpf(1.0f + __builtin_amdgcn_exp2f(-1.4426950408889634f * a)); }

struct EpiSwiGLU {
    static constexpr bool PERM = true, AFTER_DRAIN = false;
    bf16_t* O; int ldc;
    __device__ __forceinline__ void operator()(const f32x4 (&acc)[2][2][4][2], const Unit& u, int wr, int wc, int fr, int fq) const {
        const int row0 = u.pm * BM + wr * 64 + fr, col0 = u.pn * HALF + wc * 32 + 8 * fq;
#pragma unroll
        for (int ai = 0; ai < 2; ++ai)
#pragma unroll
            for (int m = 0; m < 4; ++m) { bf16_t* rowp = O + (size_t)(row0 + ai * HALF + m * 16) * ldc + col0;
                const f32x4 a0 = acc[ai][0][m][0], a1 = acc[ai][0][m][1], u0 = acc[ai][1][m][0], u1 = acc[ai][1][m][1];
                u32x4 w; w.x = cvt_pk_bf16(silu_f(a0[0]) * u0[0], silu_f(a0[1]) * u0[1]); w.y = cvt_pk_bf16(silu_f(a0[2]) * u0[2], silu_f(a0[3]) * u0[3]);
                w.z = cvt_pk_bf16(silu_f(a1[0]) * u1[0], silu_f(a1[1]) * u1[1]); w.w = cvt_pk_bf16(silu_f(a1[2]) * u1[2], silu_f(a1[3]) * u1[3]);
                *(u32x4*)rowp = w; }
    }
};
struct EpiSplit {
    static constexpr bool PERM = true, AFTER_DRAIN = false;
    bf16_t* O; int ldc; int split_cols; size_t split_stride; float scale0;
    __device__ __forceinline__ void operator()(const f32x4 (&acc)[2][2][4][2], const Unit& u, int wr, int wc, int fr, int fq) const {
        const int row0 = u.pm * BM + wr * 64 + fr; int colt = u.pn * BM; bf16_t* base = O;
        const int t = colt / split_cols; base += (size_t)t * split_stride; colt -= t * split_cols; const float sc = (t == 0) ? scale0 : 1.f;
        const int col0 = colt + wc * 32 + 8 * fq;
#pragma unroll
        for (int ai = 0; ai < 2; ++ai)
#pragma unroll
            for (int m = 0; m < 4; ++m) { bf16_t* rowp = base + (size_t)(row0 + ai * HALF + m * 16) * ldc + col0;
#pragma unroll
                for (int bj = 0; bj < 2; ++bj) { const f32x4 v0 = acc[ai][bj][m][0] * sc, v1 = acc[ai][bj][m][1] * sc;
                    u32x4 w; w.x = cvt_pk_bf16(v0[0], v0[1]); w.y = cvt_pk_bf16(v0[2], v0[3]); w.z = cvt_pk_bf16(v1[0], v1[1]); w.w = cvt_pk_bf16(v1[2], v1[3]);
                    *(u32x4*)(rowp + bj * HALF) = w; } }
    }
};
struct EpiResid {
    static constexpr bool PERM = false, AFTER_DRAIN = false;
    const float* base; float* out; int ldc; const float* gate; float wgt, alpha;
    __device__ __forceinline__ void operator()(const f32x4 (&acc)[2][2][4][2], const Unit& u, int wr, int wc, int fr, int fq) const {
        const int row0 = u.pm * BM + wr * 64 + fr, col0 = u.pn * BM + wc * 32 + 4 * fq;
        f32x4 gv[2][2];
#pragma unroll
        for (int bj = 0; bj < 2; ++bj)
#pragma unroll
            for (int n = 0; n < 2; ++n) gv[bj][n] = (*(const f32x4*)(gate + col0 + bj * HALF + n * 16) + 1.0f) * wgt;
#pragma unroll
        for (int ai = 0; ai < 2; ++ai)
#pragma unroll
            for (int m = 0; m < 4; ++m) { const size_t off = (size_t)(row0 + ai * HALF + m * 16) * ldc + col0;
#pragma unroll
                for (int bj = 0; bj < 2; ++bj)
#pragma unroll
                    for (int n = 0; n < 2; ++n) { const f32x4 bs = *(const f32x4*)(base + off + bj * HALF + n * 16);
                        *(f32x4*)(out + off + bj * HALF + n * 16) = bs * alpha + gv[bj][n] * acc[ai][bj][m][n]; }
                asm volatile("" ::: "memory"); }
    }
};

template <class Epi, class Sched, bool ALIGN_EPI = false, bool SP2 = false>
__device__ __forceinline__ void gemm_phase(PG8_LAS unsigned char* lds, const Gemm g, const Sched& S, const Epi& E) {
    int tid_l = threadIdx.x; asm volatile("" : "+v"(tid_l));
    const int tid = tid_l, wid = __builtin_amdgcn_readfirstlane(tid >> 6), lane = tid & 63, wr = wid >> 2, wc = wid & 3, fr = lane & 15, fq = lane >> 4;
    const int K = g.K, nt = K / BK;
    unsigned voffA[2], voffB[2];
#pragma unroll
    for (int i = 0; i < 2; ++i) { int R, C; stage_rc(tid * 16 + i * 8192, R, C); const int Rb = Epi::PERM ? ((R & ~31) + perm32(R & 31)) : R;
        voffA[i] = (unsigned)(R * K + C) * 2u; voffB[i] = (unsigned)(Rb * K + C) * 2u; }
    const size_t kstep = (size_t)(BK * 2);
    const size_t hstep = (size_t)HALF * K * 2;
    const size_t tstep = 2 * hstep;
    const unsigned ldsw = (unsigned)wid * 1024u;
    const int aoff = lds_byte(wr * 64 + fr, fq * 8), boff = lds_byte(wc * 32 + fr, fq * 8);
#define PG8_SA(b, h) (((b) * 2 + (h)) * HTB)
#define PG8_SB(b, h) ((4 + (b) * 2 + (h)) * HTB)
#define PG8_STAGE(bufoff, gbase, voff) do { _Pragma("unroll") for (int _i = 0; _i < 2; ++_i) \
        __builtin_amdgcn_global_load_lds((const unsigned*)((const char*)(gbase) + (voff)[_i]), (PG8_LAS unsigned*)(lds + (bufoff) + ldsw + _i * 8192), 16, 0, 0); } while (0)
#define PG8_LDA(dst, b, h) do { _Pragma("unroll") for (int m = 0; m < 4; ++m) _Pragma("unroll") for (int k = 0; k < 2; ++k) dst[m][k] = *(const PG8_LAS bf16x8*)(lds + PG8_SA(b, h) + aoff + m * 2048 + k * 1024); } while (0)
#define PG8_LDB(dst, b, h) do { _Pragma("unroll") for (int n = 0; n < 2; ++n) _Pragma("unroll") for (int k = 0; k < 2; ++k) dst[n][k] = *(const PG8_LAS bf16x8*)(lds + PG8_SB(b, h) + boff + n * 2048 + k * 1024); } while (0)
#define PG8_MMA(ai, bj, At, Bt) do { __builtin_amdgcn_s_setprio(1); _Pragma("unroll") for (int m = 0; m < 4; ++m) _Pragma("unroll") for (int n = 0; n < 2; ++n) _Pragma("unroll") for (int k = 0; k < 2; ++k) \
        acc[ai][bj][m][n] = __builtin_amdgcn_mfma_f32_16x16x32_bf16(Bt[n][k], At[m][k], acc[ai][bj][m][n], 0, 0, 0); __builtin_amdgcn_s_setprio(0); } while (0)
#define PG8_WAIT_V(n) asm volatile("s_waitcnt vmcnt(" #n ")" ::: "memory")
#define PG8_WAIT_L(n) asm volatile("s_waitcnt lgkmcnt(" #n ")" ::: "memory")
#define PG8_BAR __builtin_amdgcn_s_barrier()
#define PG8_SCHED __builtin_amdgcn_sched_barrier(0)
    Unit cur, nxt; int ui = 0;
    if (!S.next(0, cur)) return;
    f32x4 acc[2][2][4][2];
#pragma unroll
    for (int a = 0; a < 2; ++a)
#pragma unroll
        for (int b = 0; b < 2; ++b)
#pragma unroll
            for (int m = 0; m < 4; ++m)
#pragma unroll
                for (int n = 0; n < 2; ++n) acc[a][b][m][n] = (f32x4){0.f, 0.f, 0.f, 0.f};
    bf16x8 At[4][2], B0[2][2], B1[2][2];
    const char* cA = (const char*)g.A + (size_t)cur.pm * tstep; const char* cB = (const char*)g.Bt + (size_t)cur.pn * tstep;
    S.a_ready(cur);
    if constexpr (SP2) {
        PG8_STAGE(PG8_SB(0, 0), cB, voffB); PG8_STAGE(PG8_SB(0, 1), cB + hstep, voffB); PG8_STAGE(PG8_SA(0, 0), cA, voffA); PG8_STAGE(PG8_SA(0, 1), cA + hstep, voffA);
        if (wr == 1) PG8_BAR;
        PG8_WAIT_V(2); PG8_BAR;
        PG8_STAGE(PG8_SB(1, 0), cB + kstep, voffB); PG8_STAGE(PG8_SA(1, 0), cA + kstep, voffA); PG8_STAGE(PG8_SB(1, 1), cB + hstep + kstep, voffB);
        PG8_WAIT_V(6); PG8_BAR;
    } else {
        PG8_STAGE(PG8_SB(0, 0), cB, voffB); PG8_STAGE(PG8_SA(0, 0), cA, voffA); PG8_STAGE(PG8_SB(0, 1), cB + hstep, voffB); PG8_STAGE(PG8_SA(0, 1), cA + hstep, voffA);
        if (wr == 1) PG8_BAR;
        PG8_WAIT_V(4); PG8_BAR;
        PG8_STAGE(PG8_SB(1, 0), cB + kstep, voffB); PG8_STAGE(PG8_SA(1, 0), cA + kstep, voffA); PG8_STAGE(PG8_SB(1, 1), cB + hstep + kstep, voffB);
        PG8_WAIT_V(6); PG8_BAR;
    }
    for (;;) {
        const bool has_next = S.next(ui + 1, nxt);
        const char* nA = has_next ? (const char*)g.A + (size_t)nxt.pm * tstep : cA; const char* nB = has_next ? (const char*)g.Bt + (size_t)nxt.pn * tstep : cB;
        for (int t = 0; t < nt; t += 2) {
            const bool last = (t == nt - 2);
            const char* a1 = cA + (size_t)(t + 1) * kstep;
            const char* a2 = last ? nA : cA + (size_t)(t + 2) * kstep; const char* b2 = last ? nB : cB + (size_t)(t + 2) * kstep;
            const char* a3 = a2 + kstep; const char* b3 = b2 + kstep;
            if (last && has_next) S.a_ready(nxt);
            if constexpr (SP2) {
            PG8_LDB(B0, 0, 0); PG8_LDB(B1, 0, 1); PG8_SCHED; PG8_LDA(At, 0, 0); PG8_STAGE(PG8_SA(1, 1), a1 + hstep, voffA);
            PG8_WAIT_V(8); PG8_WAIT_L(0); PG8_BAR; PG8_MMA(0, 0, At, B0); PG8_MMA(0, 1, At, B1); PG8_BAR; PG8_SCHED;
            PG8_LDA(At, 0, 1); PG8_STAGE(PG8_SB(0, 0), b2, voffB); PG8_STAGE(PG8_SB(0, 1), b2 + hstep, voffB); PG8_STAGE(PG8_SA(0, 0), a2, voffA);
            PG8_WAIT_V(8); PG8_WAIT_L(0); PG8_BAR; PG8_MMA(1, 0, At, B0); PG8_MMA(1, 1, At, B1); PG8_BAR; PG8_SCHED;
            PG8_LDB(B0, 1, 0); PG8_LDB(B1, 1, 1); PG8_SCHED; PG8_LDA(At, 1, 0); PG8_STAGE(PG8_SA(0, 1), a2 + hstep, voffA);
            PG8_WAIT_V(8); PG8_WAIT_L(0); PG8_BAR; PG8_MMA(0, 0, At, B0); PG8_MMA(0, 1, At, B1); PG8_BAR; PG8_SCHED;
            PG8_LDA(At, 1, 1); PG8_STAGE(PG8_SB(1, 0), b3, voffB); PG8_STAGE(PG8_SB(1, 1), b3 + hstep, voffB); PG8_STAGE(PG8_SA(1, 0), a3, voffA);
            PG8_WAIT_V(8); PG8_WAIT_L(0); PG8_BAR; PG8_MMA(1, 0, At, B0); PG8_MMA(1, 1, At, B1); PG8_BAR; PG8_SCHED;
            } else {
            PG8_LDB(B0, 0, 0); PG8_SCHED; PG8_LDA(At, 0, 0); PG8_STAGE(PG8_SA(1, 1), a1 + hstep, voffA);
            PG8_WAIT_L(8); PG8_BAR; PG8_WAIT_L(0); PG8_MMA(0, 0, At, B0); PG8_BAR; PG8_SCHED;
            PG8_LDB(B1, 0, 1); PG8_STAGE(PG8_SB(0, 0), b2, voffB);
            PG8_BAR; PG8_WAIT_L(0); PG8_MMA(0, 1, At, B1); PG8_BAR;
            PG8_LDA(At, 0, 1); PG8_STAGE(PG8_SA(0, 0), a2, voffA);
            PG8_BAR; PG8_WAIT_L(0); PG8_MMA(1, 0, At, B0); PG8_BAR; PG8_SCHED;
            PG8_STAGE(PG8_SB(0, 1), b2 + hstep, voffB);
            PG8_WAIT_V(6); PG8_BAR; PG8_MMA(1, 1, At, B1); PG8_BAR;
            PG8_LDB(B0, 1, 0); PG8_SCHED; PG8_LDA(At, 1, 0); PG8_STAGE(PG8_SA(0, 1), a2 + hstep, voffA);
            PG8_WAIT_L(8); PG8_BAR; PG8_WAIT_L(0); PG8_MMA(0, 0, At, B0); PG8_BAR; PG8_SCHED;
            PG8_LDB(B1, 1, 1); PG8_STAGE(PG8_SB(1, 0), b3, voffB);
            PG8_BAR; PG8_WAIT_L(0); PG8_MMA(0, 1, At, B1); PG8_BAR;
            PG8_LDA(At, 1, 1); PG8_STAGE(PG8_SA(1, 0), a3, voffA);
            PG8_BAR; PG8_WAIT_L(0); PG8_MMA(1, 0, At, B0); PG8_BAR; PG8_SCHED;
            PG8_STAGE(PG8_SB(1, 1), b3 + hstep, voffB);
            PG8_WAIT_V(6); PG8_BAR; PG8_MMA(1, 1, At, B1); PG8_BAR;
            }
        }
        if constexpr (ALIGN_EPI) { if (wr == 0) PG8_BAR; }
        if constexpr (!Epi::AFTER_DRAIN) { E(acc, cur, wr, wc, fr, fq); S.done(cur); }
        if (!has_next) break;
#pragma unroll
        for (int a = 0; a < 2; ++a)
#pragma unroll
            for (int b = 0; b < 2; ++b)
#pragma unroll
                for (int m = 0; m < 4; ++m)
#pragma unroll
                    for (int n = 0; n < 2; ++n) acc[a][b][m][n] = (f32x4){0.f, 0.f, 0.f, 0.f};
        cur = nxt; cA = nA; cB = nB; ++ui;
        if constexpr (ALIGN_EPI) { if (wr == 1) PG8_BAR; }
    }
    PG8_WAIT_V(0);
    if constexpr (!ALIGN_EPI) { if (wr == 0) PG8_BAR; }
    PG8_BAR;
    if constexpr (Epi::AFTER_DRAIN) { E.fused(acc, cur, wr, wc, fr, fq, lds, wid, lane); S.done(cur); }
#undef PG8_SA
#undef PG8_SB
#undef PG8_STAGE
#undef PG8_LDA
#undef PG8_LDB
#undef PG8_MMA
#undef PG8_WAIT_V
#undef PG8_WAIT_L
#undef PG8_BAR
#undef PG8_SCHED
}
}
constexpr int NWAVES = 8;
constexpr int S_ = 16384, DM = 2048, DFF = 5632, N1 = 2 * DFF, NZ = 6144, NIN = 6152, NMOD = 9 * DM;
constexpr float LN_EPS = 1e-5f, ALPHA = 1.4142135623730951f, QSCALE = 0.08838834764831845f;
#ifndef MK_ONE_LAUNCH
#define MK_ONE_LAUNCH 1
#endif
constexpr int N_STEPS = 2 + 2 * 11;

constexpr size_t MiB = 1u << 20;
constexpr size_t WS_CTL = 0, CTL_ZERO_BYTES = 2 * MiB;
constexpr size_t WS_MOD = 2 * MiB;
constexpr size_t WS_WG = 2 * MiB + 256 * 1024;
constexpr size_t WS_GATES = 3 * MiB;
constexpr size_t WS_BCUM = 3 * MiB + 512 * 1024;
constexpr size_t WS_W1T = 4 * MiB;
constexpr size_t WS_W2T = 180 * MiB;
constexpr size_t WS_WINT = 268 * MiB;
constexpr size_t WS_WOUTT = 316 * MiB;
constexpr size_t WS_X = 332 * MiB;
constexpr size_t WS_HB = 460 * MiB;
constexpr size_t WS_YCAT = 524 * MiB;
constexpr size_t WS_BIG = 588 * MiB;
constexpr size_t WS_QKC = 780 * MiB;
constexpr size_t WS_END = 844 * MiB;
constexpr size_t ZT = (size_t)S_ * 1024;
constexpr int CW_TMO = 0, CW_BAR = 4096;

constexpr int RING_OFF = 0, RING_BYTES = 131072;
constexpr int LDSCTL_OFF = RING_BYTES, MISC_OFF = LDSCTL_OFF + 320;
constexpr int LDS_BYTES = 147456;

#define GAS __attribute__((address_space(1)))
#define LAS __attribute__((address_space(3)))
typedef unsigned short bf16;
typedef unsigned v4u __attribute__((ext_vector_type(4)));
typedef unsigned v2u __attribute__((ext_vector_type(2)));
typedef float f32x4 __attribute__((ext_vector_type(4)));
typedef float f32x2 __attribute__((ext_vector_type(2)));
#define LDS_WAIT() asm volatile("s_waitcnt lgkmcnt(0)" ::: "memory")
#define VM_WAIT() asm volatile("s_waitcnt vmcnt(0)" ::: "memory")
__device__ __forceinline__ unsigned f2bf(float f) { unsigned u = __builtin_bit_cast(unsigned, f); return (u + 0x7fffu + ((u >> 16) & 1u)) >> 16; }
__device__ __forceinline__ unsigned pk2(float lo, float hi) { return f2bf(lo) | (f2bf(hi) << 16); }
__device__ __forceinline__ float bflo(unsigned u) { return __builtin_bit_cast(float, u << 16); }
__device__ __forceinline__ float bfhi(unsigned u) { return __builtin_bit_cast(float, u & 0xffff0000u); }
__device__ __forceinline__ float bf1(bf16 u) { return __builtin_bit_cast(float, (unsigned)u << 16); }
__device__ __forceinline__ float wave_sum(float v) {
#pragma unroll
    for (int o = 1; o < 64; o <<= 1) v += __shfl_xor(v, o);
    return v;
}
__device__ __forceinline__ float sigmoid_f(float a) { return 1.0f / (1.0f + __expf(-a)); }
__device__ __forceinline__ float silu_full(float a) { return a / (1.0f + __expf(-a)); }
__device__ __forceinline__ float softplus_f(float z) { return fmaxf(z, 0.f) + log1pf(__expf(-fabsf(z))); }
#define XB_TMO      128
#define XB_XCNT(j)  (256  + 64 * (j))
#define XB_XSUB(j)  (1280 + 64 * (j))
#define XB_XGEN(j)  (2304 + 64 * (j))
#define XB_TOP      3328
#define XB_TOPGEN   3392
#define XCD_BAR_WORDS 3456
#define XB_SPIN_CAP (1u << 23)

__device__ __forceinline__ unsigned xb_ld(unsigned* p)              { return __hip_atomic_load(p, __ATOMIC_RELAXED, __HIP_MEMORY_SCOPE_AGENT); }
__device__ __forceinline__ unsigned xb_add(unsigned* p, unsigned v) { return __hip_atomic_fetch_add(p, v, __ATOMIC_RELAXED, __HIP_MEMORY_SCOPE_AGENT); }
__device__ __forceinline__ unsigned xb_xcc_id() { return (unsigned)__builtin_amdgcn_s_getreg((3 << 11) | 20) & 0xFu; }
#define XB_SPIN(cond, bar) do { unsigned _sp = 0; while (cond) { __builtin_amdgcn_s_sleep(1); \
    if ((++_sp & 255u) == 0u) { if (xb_ld(&(bar)[XB_TMO])) break; if (_sp > XB_SPIN_CAP) { atomicAdd(&(bar)[XB_TMO], 1u); break; } } } } while (0)

struct XcdBarrier {
    unsigned* bar; unsigned x;
    volatile LAS unsigned* st;
};

__device__ __forceinline__ XcdBarrier xcd_barrier_post(unsigned* bar, volatile LAS unsigned* st) {
    XcdBarrier b; b.bar = bar; b.x = xb_xcc_id(); b.st = st;
    if (threadIdx.x == 0) (void)xb_add(&bar[XB_XCNT(b.x)], 1u);
    return b;
}
__device__ __forceinline__ void xcd_barrier_complete(unsigned* bar, unsigned x, unsigned& nloc, unsigned& nx) {
    const unsigned G = gridDim.x * gridDim.y * gridDim.z;
    unsigned sum, cnt, mine, sp = 0u;
    for (;;) {
        sum = 0u; cnt = 0u; mine = 0u;
#pragma unroll
        for (unsigned j = 0; j < 16; ++j) { const unsigned c = xb_ld(&bar[XB_XCNT(j)]); sum += c; cnt += (c > 0u) ? 1u : 0u; mine = (j == x) ? c : mine; }
        if (sum == G) break;
        __builtin_amdgcn_s_sleep(1);
        if ((++sp & 255u) == 0u) { if (xb_ld(&bar[XB_TMO])) break; if (sp > XB_SPIN_CAP) { atomicAdd(&bar[XB_TMO], 1u); break; } }
    }
    nloc = mine > 0u ? mine : 1u; nx = cnt > 0u ? cnt : 1u;
}

__device__ __forceinline__ void xcd_barrier(const XcdBarrier& b) {
    asm volatile("s_waitcnt vmcnt(0)" ::: "memory");
    __syncthreads();
    if (threadIdx.x == 0) {
        unsigned* bar = b.bar;
        __builtin_amdgcn_s_waitcnt(0);
        unsigned nloc = b.st[0], nx = b.st[1];
        if (nloc == 0u) { xcd_barrier_complete(bar, b.x, nloc, nx); b.st[0] = nloc; b.st[1] = nx; }
        const unsigned old = xb_add(&bar[XB_XSUB(b.x)], 1u);
        const unsigned gen = old / nloc;
        if (old + 1u == (gen + 1u) * nloc) {
            __builtin_amdgcn_fence(__ATOMIC_RELEASE, "agent");
            asm volatile("s_waitcnt vmcnt(0)" ::: "memory");
            const unsigned og = xb_add(&bar[XB_TOP], 1u);
            const unsigned tg = og / nx;
            if (og + 1u == (tg + 1u) * nx) xb_add(&bar[XB_TOPGEN], 1u);
            else XB_SPIN(xb_ld(&bar[XB_TOPGEN]) == tg, bar);
            __builtin_amdgcn_fence(__ATOMIC_ACQUIRE, "agent");
            xb_add(&bar[XB_XGEN(b.x)], 1u);
            asm volatile("s_waitcnt vmcnt(0)" ::: "memory");
        } else {
            XB_SPIN(xb_ld(&bar[XB_XGEN(b.x)]) == gen, bar);
            __builtin_amdgcn_fence(__ATOMIC_ACQUIRE, "agent");
            asm volatile("s_waitcnt vmcnt(0)" ::: "memory");
        }
    }
    __syncthreads();
}
__device__ __forceinline__ void p0_transpose_item(const float* W, int ldw, int K, bf16* WT, int k0, int nsrc0, int dstrow0, LAS float* scr, int lane) {
#pragma unroll 8
    for (int i = 0; i < 32; ++i) { const int kk = 2 * i + (lane >> 5); scr[kk * 33 + (lane & 31)] = W[(size_t)(k0 + kk) * ldw + nsrc0 + (lane & 31)]; }
    LDS_WAIT(); asm volatile("" ::: "memory");
    const int c = lane & 7;
#pragma unroll
    for (int j = 0; j < 4; ++j) { const int n = (lane >> 3) + 8 * j; const LAS float* s = scr + (8 * c) * 33 + n;
        v4u o; o.x = pk2(s[0 * 33], s[1 * 33]); o.y = pk2(s[2 * 33], s[3 * 33]); o.z = pk2(s[4 * 33], s[5 * 33]); o.w = pk2(s[6 * 33], s[7 * 33]);
        *(GAS v4u*)(WT + (size_t)(dstrow0 + n) * K + k0 + 8 * c) = o; }
    LDS_WAIT(); asm volatile("" ::: "memory");
}
__device__ __forceinline__ int w1_dst_row(int n0) { const int h = n0 / DFF, r = n0 - h * DFF; return 256 * (r / 128) + 128 * h + (r % 128); }

__device__ __forceinline__ void ph_prologue(const float* cvec, const float* ada_w, const float* ada_b, const float* w1a, const float* w2a, const float* win, const float* wout, const float* w1b, const float* w2b,
                                            unsigned char* ws, LAS unsigned char* lds, int tid, int lane, int wave, int G) {
    {
        float* mod = (float*)(ws + WS_MOD);
        LAS float* red = (LAS float*)(lds + 12288);
        for (int it = blockIdx.x; it < 2 * (NMOD / 128); it += G) {
            const int l = it / (NMOD / 128), n0 = (it % (NMOD / 128)) * 128;
            const float* W = ada_w + (size_t)l * DM * NMOD + n0 + 2 * lane;
            float ax = 0.f, ay = 0.f;
#pragma unroll 8
            for (int k = wave * 256; k < wave * 256 + 256; ++k) { const float cv = cvec[k]; const float sc = silu_full(cv); const f32x2 w = *(const f32x2*)(W + (size_t)k * NMOD); ax += sc * w.x; ay += sc * w.y; }
            red[wave * 128 + 2 * lane] = ax; red[wave * 128 + 2 * lane + 1] = ay;
            __syncthreads();
            if (tid < 128) { float s = 0.f;
#pragma unroll
                for (int w = 0; w < 8; ++w) s += red[w * 128 + tid];
                mod[l * NMOD + n0 + tid] = s + ada_b[l * NMOD + n0 + tid]; }
            __syncthreads();
        }
    }
    {
        LAS float* scr = (LAS float*)(lds + wave * 16384);
        const int gw = blockIdx.x * NWAVES + wave, NGW = G * NWAVES;
        constexpr int I1 = (DM / 64) * (N1 / 32), I2 = (DFF / 64) * (DM / 32), I3 = (DM / 64) * (NZ / 32), I4 = (DM / 64) * (DM / 32), IL = 2 * I1 + 2 * I2 + I3 + I4;
        for (int it = gw; it < 2 * IL; it += NGW) {
            const int l = it / IL; int r = it - l * IL;
            if (r < 2 * I1) { const int f = r / I1; r -= f * I1; const int kb = r / (N1 / 32), nb = r % (N1 / 32);
                p0_transpose_item((f ? w1b : w1a) + (size_t)l * DM * N1, N1, DM, (bf16*)(ws + WS_W1T) + (size_t)(l * 2 + f) * N1 * DM, 64 * kb, 32 * nb, w1_dst_row(32 * nb), scr, lane); continue; }
            r -= 2 * I1;
            if (r < 2 * I2) { const int f = r / I2; r -= f * I2; const int kb = r / (DM / 32), nb = r % (DM / 32);
                p0_transpose_item((f ? w2b : w2a) + (size_t)l * DFF * DM, DM, DFF, (bf16*)(ws + WS_W2T) + (size_t)(l * 2 + f) * DM * DFF, 64 * kb, 32 * nb, 32 * nb, scr, lane); continue; }
            r -= 2 * I2;
            if (r < I3) { const int kb = r / (NZ / 32), nb = r % (NZ / 32);
                p0_transpose_item(win + (size_t)l * DM * NIN, NIN, DM, (bf16*)(ws + WS_WINT) + (size_t)l * NZ * DM, 64 * kb, 32 * nb, 32 * nb, scr, lane); continue; }
            r -= I3;
            { const int kb = r / (DM / 32), nb = r % (DM / 32);
                p0_transpose_item(wout + (size_t)l * DM * DM, DM, DM, (bf16*)(ws + WS_WOUTT) + (size_t)l * DM * DM, 64 * kb, 32 * nb, 32 * nb, scr, lane); }
        }
    }
    {
        float* Wg = (float*)(ws + WS_WG);
        for (int i = blockIdx.x * 512 + tid; i < 2 * 8 * DM; i += G * 512) { const int l = i / (8 * DM), e = (i / DM) % 8, k = i % DM; Wg[i] = win[((size_t)l * DM + k) * NIN + NZ + e]; }
    }
}

__device__ __forceinline__ void ph_modulate(const float* x, const float* shift, const float* scale, bf16* Hb, int lane, int wave, int G) {
    f32x4 sc[8], sh[8];
#pragma unroll
    for (int j = 0; j < 8; ++j) { sc[j] = *(const f32x4*)(scale + 4 * lane + 256 * j) + 1.0f; sh[j] = *(const f32x4*)(shift + 4 * lane + 256 * j); }
    const int gw = blockIdx.x * NWAVES + wave, NGW = G * NWAVES;
    for (int m = gw; m < S_; m += NGW) {
        const f32x4* xr = (const f32x4*)(x + (size_t)m * DM) + lane; v2u* o8 = (v2u*)(Hb + (size_t)m * DM) + lane;
#pragma unroll
        for (int j = 0; j < 8; ++j) { const f32x4 h = xr[64 * j] * sc[j] + sh[j]; v2u w; w.x = pk2(h.x, h.y); w.y = pk2(h.z, h.w); o8[64 * j] = w; }
    }
}

__device__ __forceinline__ void ph_ln(const float* Y, float* Xout, const float* g, const float* b, const float* shift, const float* scale, bf16* Hb,
                                      const float* Wg, float* gates, LAS unsigned char* lds, int tid, int lane, int wave, int G) {
    LAS float* WgL = (LAS float*)lds;
    if (Wg) { for (int i = tid; i < 8 * DM / 4; i += 512) ((LAS f32x4*)WgL)[i] = ((const f32x4*)Wg)[i]; __syncthreads(); }
    const int gw = blockIdx.x * NWAVES + wave, NGW = G * NWAVES;
    for (int m = gw; m < S_; m += NGW) {
        const f32x4* yr = (const f32x4*)(Y + (size_t)m * DM) + lane;
        f32x4 v[8]; float s = 0.f;
#pragma unroll
        for (int j = 0; j < 8; ++j) { v[j] = yr[64 * j]; s += (v[j].x + v[j].y) + (v[j].z + v[j].w); }
        const float mean = wave_sum(s) * (1.f / DM); float s2 = 0.f;
#pragma unroll
        for (int j = 0; j < 8; ++j) { v[j] = v[j] - mean; s2 += (v[j].x * v[j].x + v[j].y * v[j].y) + (v[j].z * v[j].z + v[j].w * v[j].w); }
        const float rstd = 1.f / sqrtf(wave_sum(s2) * (1.f / DM) + LN_EPS);
        f32x4* xo = (f32x4*)(Xout + (size_t)m * DM) + lane;
#pragma unroll
        for (int j = 0; j < 8; ++j) { v[j] = v[j] * rstd * *(const f32x4*)(g + 4 * lane + 256 * j) + *(const f32x4*)(b + 4 * lane + 256 * j); xo[64 * j] = v[j]; }
        if (scale) {
            v2u* o8 = (v2u*)(Hb + (size_t)m * DM) + lane;
#pragma unroll
            for (int j = 0; j < 8; ++j) { v[j] = v[j] * (*(const f32x4*)(scale + 4 * lane + 256 * j) + 1.0f) + *(const f32x4*)(shift + 4 * lane + 256 * j); v2u w; w.x = pk2(v[j].x, v[j].y); w.y = pk2(v[j].z, v[j].w); o8[64 * j] = w; }
            if (Wg) {
#pragma unroll
                for (int e = 0; e < 8; ++e) { float p = 0.f;
#pragma unroll
                    for (int j = 0; j < 8; ++j) { const f32x4 w = *(const LAS f32x4*)(WgL + e * DM + 4 * lane + 256 * j); p += (v[j].x * w.x + v[j].y * w.y) + (v[j].z * w.z + v[j].w * w.w); }
                    p = wave_sum(p); if (lane == 0) gates[(size_t)m * 8 + e] = p; }
            }
        }
    }
    if (Wg) __syncthreads();
}

__device__ __forceinline__ void ph_prep_naive(const bf16* Z3, const float* cw, const float* cb, const float* gates, const float* gb, float* QKC, double* Bc,
                                              LAS unsigned char* lds, int tid, int G) {
    for (size_t i = (size_t)blockIdx.x * 512 + tid; i < (size_t)S_ * 1024; i += (size_t)G * 512) {
        const int t = (int)(i >> 10), c = (int)(i & 1023); float a = cb[c];
#pragma unroll
        for (int k = 0; k < 4; ++k) { const int tt = t - 3 + k; if (tt >= 0) a += cw[k * 1024 + c] * bf1(Z3[(size_t)tt * 1024 + c]); }
        a = silu_full(a); if (c < 512) a *= QSCALE; QKC[i] = a;
    }
    if (blockIdx.x < 4) {
        const int hd = blockIdx.x; LAS double* part = (LAS double*)lds; const float fb = gb[4 + hd];
        double s = 0.0;
        for (int t = tid * 32; t < tid * 32 + 32; ++t) s += (double)(-softplus_f(-(gates[(size_t)t * 8 + 4 + hd] + fb)));
        part[tid] = s; __syncthreads();
        double pre = 0.0; for (int i = 0; i < tid; ++i) pre += part[i];
        for (int t = tid * 32; t < tid * 32 + 32; ++t) { pre += (double)(-softplus_f(-(gates[(size_t)t * 8 + 4 + hd] + fb))); Bc[(size_t)hd * S_ + t] = pre; }
        __syncthreads();
    }
}

__device__ __forceinline__ void ph_mix_naive(const bf16* Z, const float* QKC, const double* Bc, const float* gates, const float* gb, const float* ng, bf16* YC, int lane, int wave, int G) {
    const int gw = blockIdx.x * NWAVES + wave, NGW = G * NWAVES;
    const bf16 *Z0 = Z, *Z1 = Z + ZT, *Z2 = Z + 2 * ZT, *Z4 = Z + 4 * ZT, *Z5 = Z + 5 * ZT;
    for (int it = gw; it < S_ * 8; it += NGW) {
        const int t = it >> 3, hd = it & 7; const unsigned qq = *(const unsigned*)(Z0 + (size_t)t * 1024 + hd * 128 + 2 * lane); const float q0 = bflo(qq), q1 = bfhi(qq);
        float R = 0.f, o0 = 0.f, o1 = 0.f;
        for (int s = t - 1; s >= 0; s -= 4) {
            float p[4];
#pragma unroll
            for (int j = 0; j < 4; ++j) { const int sj = (s - j) > 0 ? (s - j) : 0; const unsigned kk = *(const unsigned*)(Z1 + (size_t)sj * 1024 + hd * 128 + 2 * lane); p[j] = q0 * bflo(kk) + q1 * bfhi(kk); }
#pragma unroll
            for (int o = 1; o < 64; o <<= 1) {
#pragma unroll
                for (int j = 0; j < 4; ++j) p[j] += __shfl_xor(p[j], o); }
#pragma unroll
            for (int j = 0; j < 4; ++j) if (s - j >= 0) { const float z = p[j], L = -softplus_f(z), a = __expf(z + L + R);
                const unsigned vv = *(const unsigned*)(Z2 + (size_t)(s - j) * 1024 + hd * 128 + 2 * lane); o0 += a * bflo(vv); o1 += a * bfhi(vv); R += L; }
            if (R < -110.f) break;
        }
        const float mean = wave_sum(o0 + o1) * (1.f / 128.f), d0 = o0 - mean, d1 = o1 - mean, var = wave_sum(d0 * d0 + d1 * d1) * (1.f / 128.f), rstd = 1.f / sqrtf(var + LN_EPS);
        const f32x2 gg = *(const f32x2*)(ng + hd * 128 + 2 * lane);
        *(unsigned*)(YC + (size_t)t * DM + hd * 128 + 2 * lane) = pk2(d0 * rstd * gg.x, d1 * rstd * gg.y);
    }
    for (int it = gw; it < S_ * 4; it += NGW) {
        const int t = it >> 2, hd = it & 3; const double Bt = Bc[(size_t)hd * S_ + t]; const float gbi = gb[hd];
        const f32x2 q = *(const f32x2*)(QKC + (size_t)t * 1024 + hd * 128 + 2 * lane);
        float den = 0.f, n0 = 0.f, n1 = 0.f, n2 = 0.f, n3 = 0.f;
        for (int s = t; s >= 0; s -= 4) {
            float p[4], wl[4];
#pragma unroll
            for (int j = 0; j < 4; ++j) { const int sj = (s - j) > 0 ? (s - j) : 0; const f32x2 k = *(const f32x2*)(QKC + (size_t)sj * 1024 + 512 + hd * 128 + 2 * lane); p[j] = q.x * k.x + q.y * k.y;
                wl[j] = (float)(Bt - Bc[(size_t)hd * S_ + sj]) + gates[(size_t)sj * 8 + hd] + gbi; }
#pragma unroll
            for (int o = 1; o < 64; o <<= 1) {
#pragma unroll
                for (int j = 0; j < 4; ++j) p[j] += __shfl_xor(p[j], o); }
#pragma unroll
            for (int j = 0; j < 4; ++j) if (s - j >= 0) { const float c = __expf(wl[j]) * p[j]; den += c;
                const v2u vv = *(const v2u*)(Z4 + (size_t)(s - j) * 1024 + hd * 256 + 4 * lane); n0 += c * bflo(vv.x); n1 += c * bfhi(vv.x); n2 += c * bflo(vv.y); n3 += c * bfhi(vv.y); }
            const int sl = (s - 3) > 0 ? (s - 3) : 0;
            if ((float)(Bt - Bc[(size_t)hd * S_ + sl]) < -150.f) break;
        }
        const float rd = 1.f / fmaxf(fabsf(den), 1.f); n0 *= rd; n1 *= rd; n2 *= rd; n3 *= rd;
        const float mean = wave_sum((n0 + n1) + (n2 + n3)) * (1.f / 256.f); n0 -= mean; n1 -= mean; n2 -= mean; n3 -= mean;
        const float var = wave_sum((n0 * n0 + n1 * n1) + (n2 * n2 + n3 * n3)) * (1.f / 256.f), rstd = 1.f / sqrtf(var + LN_EPS);
        const f32x4 gg = *(const f32x4*)(ng + 1024 + hd * 256 + 4 * lane); const v2u og = *(const v2u*)(Z5 + (size_t)t * 1024 + hd * 256 + 4 * lane);
        v2u w; w.x = pk2(n0 * rstd * gg.x * sigmoid_f(bflo(og.x)), n1 * rstd * gg.y * sigmoid_f(bfhi(og.x))); w.y = pk2(n2 * rstd * gg.z * sigmoid_f(bflo(og.y)), n3 * rstd * gg.w * sigmoid_f(bfhi(og.y)));
        *(v2u*)(YC + (size_t)t * DM + 1024 + hd * 256 + 4 * lane) = w;
    }
}
struct Args { const float* in[16]; float* out; unsigned char* ws; int st_lo, st_hi, li, pad; };
template <class T> __device__ __forceinline__ T* asg(T* p) { return (T*)(GAS T*)p; }
#define CAS __attribute__((address_space(4)))
typedef const volatile CAS Args* KArgs;
__device__ __forceinline__ KArgs kargs() { return (KArgs)__builtin_amdgcn_kernarg_segment_ptr(); }
__global__ void __launch_bounds__(NWAVES * 64, 2) fwd(Args args_unused) {
    extern __shared__ __attribute__((aligned(16))) unsigned char lds_raw[];
    LAS unsigned char* lds = (LAS unsigned char*)lds_raw;
    const int G = gridDim.x;
    for (int u = threadIdx.x; u < (LDS_BYTES - LDSCTL_OFF) / 4; u += NWAVES * 64) ((LAS unsigned*)(lds + LDSCTL_OFF))[u] = 0u;
    __syncthreads();
    int lo, hi;
    { KArgs A = kargs(); lo = A->st_lo; hi = A->st_hi;
      if (hi - lo > 1) (void)xcd_barrier_post((unsigned*)(asg(A->ws) + WS_CTL) + CW_BAR + A->li * XCD_BAR_WORDS, (volatile LAS unsigned*)(lds + MISC_OFF) + 8); }
    int st = 0;
#define TID_FRESH() int tid = threadIdx.x; asm volatile("" : "+v"(tid)); const int lane = tid & 63, wave = __builtin_amdgcn_readfirstlane(tid >> 6); (void)lane; (void)wave
#define STEP_ON() (lo <= st && st < hi)
#define STEP_END() do { if (st + 1 < hi) { KArgs A_ = kargs(); XcdBarrier bar_; bar_.bar = (unsigned*)(asg(A_->ws) + WS_CTL) + CW_BAR + A_->li * XCD_BAR_WORDS; bar_.x = xb_xcc_id(); bar_.st = (volatile LAS unsigned*)(lds + MISC_OFF) + 8; xcd_barrier(bar_); } } while (0)

    if (STEP_ON()) {
#ifndef NO_PRO
        TID_FRESH(); KArgs A = kargs();
        ph_prologue(asg(A->in[1]), asg(A->in[2]), asg(A->in[3]), asg(A->in[6]), asg(A->in[7]), asg(A->in[8]), asg(A->in[13]), asg(A->in[14]), asg(A->in[15]), asg(A->ws), lds, tid, lane, wave, G);
#endif
        STEP_END(); }
    ++st;
    if (STEP_ON()) { TID_FRESH(); KArgs A = kargs(); const float* mod = (const float*)(asg(A->ws) + WS_MOD); ph_modulate(asg(A->in[0]), mod, mod + DM, (bf16*)(asg(A->ws) + WS_HB), lane, wave, G); STEP_END(); }
    ++st;

    for (int sl = 0; sl < 6; ++sl) {
        const int l = sl / 3, sub = sl - 3 * l;
        if (sub != 1) {
            if (STEP_ON()) {
                KArgs A = kargs(); unsigned char* ws = asg(A->ws);
                pg8::Gemm g{(const bf16*)(ws + WS_HB), (const bf16*)(ws + WS_W1T) + (size_t)(l * 2 + (sub >> 1)) * N1 * DM, S_, N1, DM}; pg8::StaticOrder SO; SO.init(S_, N1, G, (int)blockIdx.x);
                pg8::EpiSwiGLU E{(bf16*)(ws + WS_BIG), DFF};
#ifndef NO_G1
                pg8::gemm_phase<pg8::EpiSwiGLU, pg8::StaticOrder, true, true>(lds + RING_OFF, g, SO, E);
#endif
                STEP_END();
            }
            ++st;
        } else {
            if (STEP_ON()) {
                KArgs A = kargs(); unsigned char* ws = asg(A->ws);
                pg8::Gemm g{(const bf16*)(ws + WS_HB), (const bf16*)(ws + WS_WINT) + (size_t)l * NZ * DM, S_, NZ, DM}; pg8::StaticOrder SO; SO.init(S_, NZ, G, (int)blockIdx.x);
                pg8::EpiSplit E{(bf16*)(ws + WS_BIG), 1024, 1024, ZT, QSCALE};
#ifndef NO_GZ
                pg8::gemm_phase<pg8::EpiSplit, pg8::StaticOrder, true, true>(lds + RING_OFF, g, SO, E);
#endif
                STEP_END();
            }
            ++st;
            if (STEP_ON()) {
#ifndef NO_NAIVE
                TID_FRESH(); KArgs A = kargs(); unsigned char* ws = asg(A->ws);
                ph_prep_naive((const bf16*)(ws + WS_BIG) + 3 * ZT, asg(A->in[9]) + (size_t)l * 4 * 1024, asg(A->in[10]) + (size_t)l * 1024, (const float*)(ws + WS_GATES), asg(A->in[11]) + l * 8, (float*)(ws + WS_QKC), (double*)(ws + WS_BCUM), lds, tid, G);
#endif
                STEP_END();
            }
            ++st;
            if (STEP_ON()) {
#ifndef NO_NAIVE
                TID_FRESH(); KArgs A = kargs(); unsigned char* ws = asg(A->ws);
                ph_mix_naive((const bf16*)(ws + WS_BIG), (const float*)(ws + WS_QKC), (const double*)(ws + WS_BCUM), (const float*)(ws + WS_GATES), asg(A->in[11]) + l * 8, asg(A->in[12]) + (size_t)l * DM, (bf16*)(ws + WS_YCAT), lane, wave, G);
#endif
                STEP_END();
            }
            ++st;
        }
        if (STEP_ON()) {
            KArgs A = kargs(); unsigned char* ws = asg(A->ws); float* X = (float*)(ws + WS_X);
            pg8::Gemm g; float wgt;
            if (sub != 1) { g = pg8::Gemm{(const bf16*)(ws + WS_BIG), (const bf16*)(ws + WS_W2T) + (size_t)(l * 2 + (sub >> 1)) * DM * DFF, S_, DM, DFF}; wgt = 0.5f; }
            else { g = pg8::Gemm{(const bf16*)(ws + WS_YCAT), (const bf16*)(ws + WS_WOUTT) + (size_t)l * DM * DM, S_, DM, DM}; wgt = 1.0f; }
            pg8::StaticOrder SO; SO.init(S_, DM, G, (int)blockIdx.x);
            pg8::EpiResid E{sl == 0 ? asg(A->in[0]) : X, X, DM, (const float*)(ws + WS_MOD) + l * NMOD + sub * 3 * DM + 2 * DM, wgt, ALPHA};
#ifndef NO_GR
            pg8::gemm_phase<pg8::EpiResid, pg8::StaticOrder, true, true>(lds + RING_OFF, g, SO, E);
#endif
            STEP_END();
        }
        ++st;
        if (STEP_ON()) {
#ifndef NO_LN
            TID_FRESH(); KArgs A = kargs(); unsigned char* ws = asg(A->ws); float* X = (float*)(ws + WS_X);
            const int ln_i = l * 3 + sub; const bool last = (sl == 5);
            const int l2 = (sl + 1) / 3, sub2 = (sl + 1) - 3 * l2; const float* modn = (const float*)(ws + WS_MOD) + l2 * NMOD + sub2 * 3 * DM;
            ph_ln(X, last ? asg(A->out) : X, asg(A->in[4]) + (size_t)ln_i * DM, asg(A->in[5]) + (size_t)ln_i * DM, last ? nullptr : modn, last ? nullptr : modn + DM, (bf16*)(ws + WS_HB),
                  (!last && sub2 == 1) ? (const float*)(ws + WS_WG) + (size_t)l2 * 8 * DM : nullptr, (float*)(ws + WS_GATES), lds, tid, lane, wave, G);
#endif
            STEP_END();
        }
        ++st;
    }
#undef STEP_ON
#undef STEP_END
}

extern "C" void kernel_launch(void* const* d_in, const int* in_sizes, int n_in, void* d_out, int out_size, void* d_ws, size_t ws_size, hipStream_t stream) {
    static int grid = 0;
    if (grid == 0) {
        if (n_in != 16 || in_sizes[0] != S_ * DM || out_size != S_ * DM || ws_size < WS_END) { fprintf(stderr, "kernel_launch: shape mismatch (n_in %d in0 %d out %d ws %zu)\n", n_in, n_in > 0 ? in_sizes[0] : -1, out_size, ws_size); grid = -1; return; }
        int dev = 0, cus = 0, per_cu = 0;
        if (hipGetDevice(&dev) != hipSuccess || hipDeviceGetAttribute(&cus, hipDeviceAttributeMultiprocessorCount, dev) != hipSuccess) { grid = -1; return; }
        if (hipFuncSetAttribute((const void*)fwd, hipFuncAttributeMaxDynamicSharedMemorySize, LDS_BYTES) != hipSuccess) { fprintf(stderr, "kernel_launch: hipFuncSetAttribute failed\n"); grid = -1; return; }
        if (hipOccupancyMaxActiveBlocksPerMultiprocessor(&per_cu, (const void*)fwd, NWAVES * 64, LDS_BYTES) != hipSuccess || per_cu < 1) fprintf(stderr, "kernel_launch: occupancy query reports %d\n", per_cu);
        (void)hipGetLastError();
        grid = cus;
    }
    if (grid < 0) return;
    if (hipMemsetAsync((char*)d_ws + WS_CTL, 0, CTL_ZERO_BYTES, stream) != hipSuccess) { fprintf(stderr, "kernel_launch: memset failed\n"); return; }
    Args a{};
    for (int i = 0; i < 16; ++i) a.in[i] = (const float*)d_in[i];
    a.out = (float*)d_out; a.ws = (unsigned char*)d_ws;
#if MK_ONE_LAUNCH
    a.st_lo = 0; a.st_hi = N_STEPS; a.li = 0;
    hipLaunchKernelGGL(fwd, dim3(grid), dim3(NWAVES * 64), LDS_BYTES, stream, a);
#else
    for (int s = 0; s < N_STEPS; ++s) { a.st_lo = s; a.st_hi = s + 1; a.li = 0; hipLaunchKernelGGL(fwd, dim3(grid), dim3(NWAVES * 64), LDS_BYTES, stream, a); }
#endif
    const hipError_t le = hipPeekAtLastError();
    if (le != hipSuccess) fprintf(stderr, "kernel_launch: launch failed: %s\n", hipGetErrorName(le));
}
```

```cpp
#include <hip/hip_runtime.h>
#include <cstdio>
#include <cstdint>
namespace pg8 {
#define PG8_LAS __attribute__((address_space(3)))
typedef unsigned short bf16_t;
typedef short bf16x8 __attribute__((ext_vector_type(8)));
typedef float f32x4 __attribute__((ext_vector_type(4)));
typedef unsigned u32x4 __attribute__((ext_vector_type(4)));
constexpr int BM = 256, BK = 64, HALF = 128, HTB = HALF * BK * 2  , STAGE_BYTES = 8 * HTB, NXCD = 8, WGM = 8;

__host__ __device__ __forceinline__ int lds_byte(int r, int c) { const int st = (r >> 4) * 2 + (c >> 5), rr = r & 15, cc = c & 31, ob = rr * 64 + cc * 2; return st * 1024 + (ob ^ (((ob >> 9) & 1) << 5)); }
__host__ __device__ __forceinline__ void stage_rc(int b, int& R, int& C) { const int st = b / 1024, sb = b % 1024, swz = sb ^ (((sb >> 9) & 1) << 5); R = (st >> 1) * 16 + swz / 64; C = (st & 1) * 32 + (swz % 64) / 2; }
__host__ __device__ __forceinline__ int perm32(int rho) { const int n = rho >> 4, i = rho & 15; return 8 * (i >> 2) + 4 * n + (i & 3); }

struct Unit { int pm, pn; };
struct Gemm { const bf16_t* A; const bf16_t* Bt; int M, N, K; };

struct StaticOrder {
    int nM, nN, nwg, G, c;
    __host__ __device__ void init(int M, int N, int G_, int c_) { nM = M / BM; nN = N / BM; nwg = nM * nN; G = G_; c = c_; }
    __host__ __device__ bool next(int i, Unit& u) const {
        const long L = (long)i * G + c; if (L >= nwg) return false;
        int wgid = (int)L; { const int q = nwg / NXCD, r = nwg % NXCD, xcd = wgid % NXCD, off = wgid / NXCD; wgid = (xcd < r ? xcd * (q + 1) : r * (q + 1) + (xcd - r) * q) + off; }
        const int nig = WGM * nN, gid = wgid / nig, fm = gid * WGM, gsz = (nM - fm) < WGM ? (nM - fm) : WGM;
        u.pm = fm + ((wgid % nig) % gsz); u.pn = (wgid % nig) / gsz; return true;
    }
    __device__ __forceinline__ void a_ready(const Unit&) const {}
    __device__ __forceinline__ void done(const Unit&) const {}
};

__device__ __forceinline__ unsigned cvt_pk_bf16(float lo, float hi) { unsigned r; asm volatile("v_cvt_pk_bf16_f32 %0, %1, %2" : "=v"(r) : "v"(lo), "v"(hi)); return r; }
__device__ __forceinline__ float silu_f(float a) { return a * __builtin_amdgcn_rcpf(1.0f + __builtin_amdgcn_exp2f(-1.4426950408889634f * a)); }

struct EpiSwiGLU {
    static constexpr bool PERM = true, AFTER_DRAIN = false;
    bf16_t* O; int ldc;
    __device__ __forceinline__ void operator()(const f32x4 (&acc)[2][2][4][2], const Unit& u, int wr, int wc, int fr, int fq) const {
        const int row0 = u.pm * BM + wr * 64 + fr, col0 = u.pn * HALF + wc * 32 + 8 * fq;
#pragma unroll
        for (int ai = 0; ai < 2; ++ai)
#pragma unroll
            for (int m = 0; m < 4; ++m) { bf16_t* rowp = O + (size_t)(row0 + ai * HALF + m * 16) * ldc + col0;
                const f32x4 a0 = acc[ai][0][m][0], a1 = acc[ai][0][m][1], u0 = acc[ai][1][m][0], u1 = acc[ai][1][m][1];
                u32x4 w; w.x = cvt_pk_bf16(silu_f(a0[0]) * u0[0], silu_f(a0[1]) * u0[1]); w.y = cvt_pk_bf16(silu_f(a0[2]) * u0[2], silu_f(a0[3]) * u0[3]);
                w.z = cvt_pk_bf16(silu_f(a1[0]) * u1[0], silu_f(a1[1]) * u1[1]); w.w = cvt_pk_bf16(silu_f(a1[2]) * u1[2], silu_f(a1[3]) * u1[3]);
                *(u32x4*)rowp = w; }
    }
};
struct EpiSplit {
    static constexpr bool PERM = true, AFTER_DRAIN = false;
    bf16_t* O; int ldc; int split_cols; size_t split_stride; float scale0;
    __device__ __forceinline__ void operator()(const f32x4 (&acc)[2][2][4][2], const Unit& u, int wr, int wc, int fr, int fq) const {
        const int row0 = u.pm * BM + wr * 64 + fr; int colt = u.pn * BM; bf16_t* base = O;
        const int t = colt / split_cols; base += (size_t)t * split_stride; colt -= t * split_cols; const float sc = (t == 0) ? scale0 : 1.f;
        const int col0 = colt + wc * 32 + 8 * fq;
#pragma unroll
        for (int ai = 0; ai < 2; ++ai)
#pragma unroll
            for (int m = 0; m < 4; ++m) { bf16_t* rowp = base + (size_t)(row0 + ai * HALF + m * 16) * ldc + col0;
#pragma unroll
                for (int bj = 0; bj < 2; ++bj) { const f32x4 v0 = acc[ai][bj][m][0] * sc, v1 = acc[ai][bj][m][1] * sc;
                    u32x4 w; w.x = cvt_pk_bf16(v0[0], v0[1]); w.y = cvt_pk_bf16(v0[2], v0[3]); w.z = cvt_pk_bf16(v1[0], v1[1]); w.w = cvt_pk_bf16(v1[2], v1[3]);
                    *(u32x4*)(rowp + bj * HALF) = w; } }
    }
};
struct EpiResid {
    static constexpr bool PERM = false, AFTER_DRAIN = false;
    const float* base; float* out; int ldc; const float* gate; float wgt, alpha;
    __device__ __forceinline__ void operator()(const f32x4 (&acc)[2][2][4][2], const Unit& u, int wr, int wc, int fr, int fq) const {
        const int row0 = u.pm * BM + wr * 64 + fr, col0 = u.pn * BM + wc * 32 + 4 * fq;
        f32x4 gv[2][2];
#pragma unroll
        for (int bj = 0; bj < 2; ++bj)
#pragma unroll
            for (int n = 0; n < 2; ++n) gv[bj][n] = (*(const f32x4*)(gate + col0 + bj * HALF + n * 16) + 1.0f) * wgt;
#pragma unroll
        for (int ai = 0; ai < 2; ++ai)
#pragma unroll
            for (int m = 0; m < 4; ++m) { const size_t off = (size_t)(row0 + ai * HALF + m * 16) * ldc + col0;
#pragma unroll
                for (int bj = 0; bj < 2; ++bj)
#pragma unroll
                    for (int n = 0; n < 2; ++n) { const f32x4 bs = *(const f32x4*)(base + off + bj * HALF + n * 16);
                        *(f32x4*)(out + off + bj * HALF + n * 16) = bs * alpha + gv[bj][n] * acc[ai][bj][m][n]; }
                asm volatile("" ::: "memory"); }
    }
};

template <class Epi, class Sched, bool ALIGN_EPI = false, bool SP2 = false>
__device__ __forceinline__ void gemm_phase(PG8_LAS unsigned char* lds, const Gemm g, const Sched& S, const Epi& E) {
    int tid_l = threadIdx.x; asm volatile("" : "+v"(tid_l));
    const int tid = tid_l, wid = __builtin_amdgcn_readfirstlane(tid >> 6), lane = tid & 63, wr = wid >> 2, wc = wid & 3, fr = lane & 15, fq = lane >> 4;
    const int K = g.K, nt = K / BK;
    unsigned voffA[2], voffB[2];
#pragma unroll
    for (int i = 0; i < 2; ++i) { int R, C; stage_rc(tid * 16 + i * 8192, R, C); const int Rb = Epi::PERM ? ((R & ~31) + perm32(R & 31)) : R;
        voffA[i] = (unsigned)(R * K + C) * 2u; voffB[i] = (unsigned)(Rb * K + C) * 2u; }
    const size_t kstep = (size_t)(BK * 2);
    const size_t hstep = (size_t)HALF * K * 2;
    const size_t tstep = 2 * hstep;
    const unsigned ldsw = (unsigned)wid * 1024u;
    const int aoff = lds_byte(wr * 64 + fr, fq * 8), boff = lds_byte(wc * 32 + fr, fq * 8);
#define PG8_SA(b, h) (((b) * 2 + (h)) * HTB)
#define PG8_SB(b, h) ((4 + (b) * 2 + (h)) * HTB)
#define PG8_STAGE(bufoff, gbase, voff) do { _Pragma("unroll") for (int _i = 0; _i < 2; ++_i) \
        __builtin_amdgcn_global_load_lds((const unsigned*)((const char*)(gbase) + (voff)[_i]), (PG8_LAS unsigned*)(lds + (bufoff) + ldsw + _i * 8192), 16, 0, 0); } while (0)
#define PG8_LDA(dst, b, h) do { _Pragma("unroll") for (int m = 0; m < 4; ++m) _Pragma("unroll") for (int k = 0; k < 2; ++k) dst[m][k] = *(const PG8_LAS bf16x8*)(lds + PG8_SA(b, h) + aoff + m * 2048 + k * 1024); } while (0)
#define PG8_LDB(dst, b, h) do { _Pragma("unroll") for (int n = 0; n < 2; ++n) _Pragma("unroll") for (int k = 0; k < 2; ++k) dst[n][k] = *(const PG8_LAS bf16x8*)(lds + PG8_SB(b, h) + boff + n * 2048 + k * 1024); } while (0)
#define PG8_MMA(ai, bj, At, Bt) do { __builtin_amdgcn_s_setprio(1); _Pragma("unroll") for (int m = 0; m < 4; ++m) _Pragma("unroll") for (int n = 0; n < 2; ++n) _Pragma("unroll") for (int k = 0; k < 2; ++k) \
        acc[ai][bj][m][n] = __builtin_amdgcn_mfma_f32_16x16x32_bf16(Bt[n][k], At[m][k], acc[ai][bj][m][n], 0, 0, 0); __builtin_amdgcn_s_setprio(0); } while (0)
#define PG8_WAIT_V(n) asm volatile("s_waitcnt vmcnt(" #n ")" ::: "memory")
#define PG8_WAIT_L(n) asm volatile("s_waitcnt lgkmcnt(" #n ")" ::: "memory")
#define PG8_BAR __builtin_amdgcn_s_barrier()
#define PG8_SCHED __builtin_amdgcn_sched_barrier(0)
    Unit cur, nxt; int ui = 0;
    if (!S.next(0, cur)) return;
    f32x4 acc[2][2][4][2];
#pragma unroll
    for (int a = 0; a < 2; ++a)
#pragma unroll
        for (int b = 0; b < 2; ++b)
#pragma unroll
            for (int m = 0; m < 4; ++m)
#pragma unroll
                for (int n = 0; n < 2; ++n) acc[a][b][m][n] = (f32x4){0.f, 0.f, 0.f, 0.f};
    bf16x8 At[4][2], B0[2][2], B1[2][2];
    const char* cA = (const char*)g.A + (size_t)cur.pm * tstep; const char* cB = (const char*)g.Bt + (size_t)cur.pn * tstep;
    S.a_ready(cur);
    if constexpr (SP2) {
        PG8_STAGE(PG8_SB(0, 0), cB, voffB); PG8_STAGE(PG8_SB(0, 1), cB + hstep, voffB); PG8_STAGE(PG8_SA(0, 0), cA, voffA); PG8_STAGE(PG8_SA(0, 1), cA + hstep, voffA);
        if (wr == 1) PG8_BAR;
        PG8_WAIT_V(2); PG8_BAR;
        PG8_STAGE(PG8_SB(1, 0), cB + kstep, voffB); PG8_STAGE(PG8_SA(1, 0), cA + kstep, voffA); PG8_STAGE(PG8_SB(1, 1), cB + hstep + kstep, voffB);
        PG8_WAIT_V(6); PG8_BAR;
    } else {
        PG8_STAGE(PG8_SB(0, 0), cB, voffB); PG8_STAGE(PG8_SA(0, 0), cA, voffA); PG8_STAGE(PG8_SB(0, 1), cB + hstep, voffB); PG8_STAGE(PG8_SA(0, 1), cA + hstep, voffA);
        if (wr == 1) PG8_BAR;
        PG8_WAIT_V(4); PG8_BAR;
        PG8_STAGE(PG8_SB(1, 0), cB + kstep, voffB); PG8_STAGE(PG8_SA(1, 0), cA + kstep, voffA); PG8_STAGE(PG8_SB(1, 1), cB + hstep + kstep, voffB);
        PG8_WAIT_V(6); PG8_BAR;
    }
    for (;;) {
        const bool has_next = S.next(ui + 1, nxt);
        const char* nA = has_next ? (const char*)g.A + (size_t)nxt.pm * tstep : cA; const char* nB = has_next ? (const char*)g.Bt + (size_t)nxt.pn * tstep : cB;
        for (int t = 0; t < nt; t += 2) {
            const bool last = (t == nt - 2);
            const char* a1 = cA + (size_t)(t + 1) * kstep;
            const char* a2 = last ? nA : cA + (size_t)(t + 2) * kstep; const char* b2 = last ? nB : cB + (size_t)(t + 2) * kstep;
            const char* a3 = a2 + kstep; const char* b3 = b2 + kstep;
            if (last && has_next) S.a_ready(nxt);
            if constexpr (SP2) {
            PG8_LDB(B0, 0, 0); PG8_LDB(B1, 0, 1); PG8_SCHED; PG8_LDA(At, 0, 0); PG8_STAGE(PG8_SA(1, 1), a1 + hstep, voffA);
            PG8_WAIT_V(8); PG8_WAIT_L(0); PG8_BAR; PG8_MMA(0, 0, At, B0); PG8_MMA(0, 1, At, B1); PG8_BAR; PG8_SCHED;
            PG8_LDA(At, 0, 1); PG8_STAGE(PG8_SB(0, 0), b2, voffB); PG8_STAGE(PG8_SB(0, 1), b2 + hstep, voffB); PG8_STAGE(PG8_SA(0, 0), a2, voffA);
            PG8_WAIT_V(8); PG8_WAIT_L(0); PG8_BAR; PG8_MMA(1, 0, At, B0); PG8_MMA(1, 1, At, B1); PG8_BAR; PG8_SCHED;
            PG8_LDB(B0, 1, 0); PG8_LDB(B1, 1, 1); PG8_SCHED; PG8_LDA(At, 1, 0); PG8_STAGE(PG8_SA(0, 1), a2 + hstep, voffA);
            PG8_WAIT_V(8); PG8_WAIT_L(0); PG8_BAR; PG8_MMA(0, 0, At, B0); PG8_MMA(0, 1, At, B1); PG8_BAR; PG8_SCHED;
            PG8_LDA(At, 1, 1); PG8_STAGE(PG8_SB(1, 0), b3, voffB); PG8_STAGE(PG8_SB(1, 1), b3 + hstep, voffB); PG8_STAGE(PG8_SA(1, 0), a3, voffA);
            PG8_WAIT_V(8); PG8_WAIT_L(0); PG8_BAR; PG8_MMA(1, 0, At, B0); PG8_MMA(1, 1, At, B1); PG8_BAR; PG8_SCHED;
            } else {
            PG8_LDB(B0, 0, 0); PG8_SCHED; PG8_LDA(At, 0, 0); PG8_STAGE(PG8_SA(1, 1), a1 + hstep, voffA);
            PG8_WAIT_L(8); PG8_BAR; PG8_WAIT_L(0); PG8_MMA(0, 0, At, B0); PG8_BAR; PG8_SCHED;
            PG8_LDB(B1, 0, 1); PG8_STAGE(PG8_SB(0, 0), b2, voffB);
            PG8_BAR; PG8_WAIT_L(0); PG8_MMA(0, 1, At, B1); PG8_BAR;
            PG8_LDA(At, 0, 1); PG8_STAGE(PG8_SA(0, 0), a2, voffA);
            PG8_BAR; PG8_WAIT_L(0); PG8_MMA(1, 0, At, B0); PG8_BAR; PG8_SCHED;
            PG8_STAGE(PG8_SB(0, 1), b2 + hstep, voffB);
            PG8_WAIT_V(6); PG8_BAR; PG8_MMA(1, 1, At, B1); PG8_BAR;
            PG8_LDB(B0, 1, 0); PG8_SCHED; PG8_LDA(At, 1, 0); PG8_STAGE(PG8_SA(0, 1), a2 + hstep, voffA);
            PG8_WAIT_L(8); PG8_BAR; PG8_WAIT_L(0); PG8_MMA(0, 0, At, B0); PG8_BAR; PG8_SCHED;
            PG8_LDB(B1, 1, 1); PG8_STAGE(PG8_SB(1, 0), b3, voffB);
            PG8_BAR; PG8_WAIT_L(0); PG8_MMA(0, 1, At, B1); PG8_BAR;
            PG8_LDA(At, 1, 1); PG8_STAGE(PG8_SA(1, 0), a3, voffA);
            PG8_BAR; PG8_WAIT_L(0); PG8_MMA(1, 0, At, B0); PG8_BAR; PG8_SCHED;
            PG8_STAGE(PG8_SB(1, 1), b3 + hstep, voffB);
            PG8_WAIT_V(6); PG8_BAR; PG8_MMA(1, 1, At, B1); PG8_BAR;
            }
        }
        if constexpr (ALIGN_EPI) { if (wr == 0) PG8_BAR; }
        if constexpr (!Epi::AFTER_DRAIN) { E(acc, cur, wr, wc, fr, fq); S.done(cur); }
        if (!has_next) break;
#pragma unroll
        for (int a = 0; a < 2; ++a)
#pragma unroll
            for (int b = 0; b < 2; ++b)
#pragma unroll
                for (int m = 0; m < 4; ++m)
#pragma unroll
                    for (int n = 0; n < 2; ++n) acc[a][b][m][n] = (f32x4){0.f, 0.f, 0.f, 0.f};
        cur = nxt; cA = nA; cB = nB; ++ui;
        if constexpr (ALIGN_EPI) { if (wr == 1) PG8_BAR; }
    }
    PG8_WAIT_V(0);
    if constexpr (!ALIGN_EPI) { if (wr == 0) PG8_BAR; }
    PG8_BAR;
    if constexpr (Epi::AFTER_DRAIN) { E.fused(acc, cur, wr, wc, fr, fq, lds, wid, lane); S.done(cur); }
#undef PG8_SA
#undef PG8_SB
#undef PG8_STAGE
#undef PG8_LDA
#undef PG8_LDB
#undef PG8_MMA
#undef PG8_WAIT_V
#undef PG8_WAIT_L
#undef PG8_BAR
#undef PG8_SCHED
}
}
constexpr int NWAVES = 8;
constexpr int S_ = 16384, DM = 2048, DFF = 5632, N1 = 2 * DFF, NZ = 6144, NIN = 6152, NMOD = 9 * DM;
constexpr float LN_EPS = 1e-5f, ALPHA = 1.4142135623730951f, QSCALE = 0.08838834764831845f, QSCALE_L2E = 0.08838834764831845f * 1.4426950408889634f;
#ifndef MK_ONE_LAUNCH
#define MK_ONE_LAUNCH 1
#endif
constexpr int N_STEPS = 2 + 2 * 12;

constexpr size_t MiB = 1u << 20;
constexpr size_t WS_CTL = 0, CTL_ZERO_BYTES = 2 * MiB;
constexpr size_t WS_MOD = 2 * MiB;
constexpr size_t WS_WG = 2 * MiB + 256 * 1024;
constexpr size_t WS_GATES = 3 * MiB;
constexpr size_t WS_BCUM = 3 * MiB + 512 * 1024;
constexpr size_t WS_W1T = 4 * MiB;
constexpr size_t WS_W2T = 180 * MiB;
constexpr size_t WS_WINT = 268 * MiB;
constexpr size_t WS_WOUTT = 316 * MiB;
constexpr size_t WS_X = 332 * MiB;
constexpr size_t WS_HB = 460 * MiB;
constexpr size_t WS_YCAT = 524 * MiB;
constexpr size_t WS_BIG = 588 * MiB;
constexpr size_t WS_QKT = 780 * MiB;
constexpr size_t WS_DC = 812 * MiB;
constexpr size_t WS_CS = 844 * MiB;
constexpr size_t WS_DN = 860 * MiB, WS_NSS = 860 * MiB + 128 * 1024;
constexpr size_t WS_BL = WS_BCUM, WS_LI = WS_BCUM + 256 * 1024;
constexpr size_t WS_BTOT = WS_MOD + 160 * 1024;
constexpr size_t WS_END = 861 * MiB;
constexpr size_t ZT = (size_t)S_ * 1024;
constexpr int CW_TMO = 0, CW_BAR = 4096;

constexpr int RING_OFF = 0, RING_BYTES = 131072;
constexpr int LDS_BYTES = 147456;
constexpr int LDSCTL_OFF = LDS_BYTES - 512, MISC_OFF = LDSCTL_OFF + 320;

#define GAS __attribute__((address_space(1)))
#define LAS __attribute__((address_space(3)))
typedef unsigned short bf16;
typedef unsigned v4u __attribute__((ext_vector_type(4)));
typedef unsigned v2u __attribute__((ext_vector_type(2)));
typedef float f32x4 __attribute__((ext_vector_type(4)));
typedef float f32x2 __attribute__((ext_vector_type(2)));
#define LDS_WAIT() asm volatile("s_waitcnt lgkmcnt(0)" ::: "memory")
#define VM_WAIT() asm volatile("s_waitcnt vmcnt(0)" ::: "memory")
__device__ __forceinline__ unsigned f2bf(float f) { unsigned u = __builtin_bit_cast(unsigned, f); return (u + 0x7fffu + ((u >> 16) & 1u)) >> 16; }
__device__ __forceinline__ unsigned pk2(float lo, float hi) { return f2bf(lo) | (f2bf(hi) << 16); }
__device__ __forceinline__ float bflo(unsigned u) { return __builtin_bit_cast(float, u << 16); }
__device__ __forceinline__ float bfhi(unsigned u) { return __builtin_bit_cast(float, u & 0xffff0000u); }
__device__ __forceinline__ float bf1(bf16 u) { return __builtin_bit_cast(float, (unsigned)u << 16); }
__device__ __forceinline__ float wave_sum(float v) {
#pragma unroll
    for (int o = 1; o < 64; o <<= 1) v += __shfl_xor(v, o);
    return v;
}
__device__ __forceinline__ float sigmoid_f(float a) { return 1.0f / (1.0f + __expf(-a)); }
__device__ __forceinline__ float silu_full(float a) { return a / (1.0f + __expf(-a)); }
__device__ __forceinline__ float softplus_f(float z) { return fmaxf(z, 0.f) + log1pf(__expf(-fabsf(z))); }
#define XB_TMO      128
#define XB_XCNT(j)  (256  + 64 * (j))
#define XB_XSUB(j)  (1280 + 64 * (j))
#define XB_XGEN(j)  (2304 + 64 * (j))
#define XB_TOP      3328
#define XB_TOPGEN   3392
#define XCD_BAR_WORDS 3456
#define XB_SPIN_CAP (1u << 23)

__device__ __forceinline__ unsigned xb_ld(unsigned* p)              { return __hip_atomic_load(p, __ATOMIC_RELAXED, __HIP_MEMORY_SCOPE_AGENT); }
__device__ __forceinline__ unsigned xb_add(unsigned* p, unsigned v) { return __hip_atomic_fetch_add(p, v, __ATOMIC_RELAXED, __HIP_MEMORY_SCOPE_AGENT); }
__device__ __forceinline__ unsigned xb_xcc_id() { return (unsigned)__builtin_amdgcn_s_getreg((3 << 11) | 20) & 0xFu; }
#define XB_SPIN(cond, bar) do { unsigned _sp = 0; while (cond) { __builtin_amdgcn_s_sleep(1); \
    if ((++_sp & 255u) == 0u) { if (xb_ld(&(bar)[XB_TMO])) break; if (_sp > XB_SPIN_CAP) { atomicAdd(&(bar)[XB_TMO], 1u); break; } } } } while (0)

struct XcdBarrier {
    unsigned* bar; unsigned x;
    volatile LAS unsigned* st;
};

__device__ __forceinline__ XcdBarrier xcd_barrier_post(unsigned* bar, volatile LAS unsigned* st) {
    XcdBarrier b; b.bar = bar; b.x = xb_xcc_id(); b.st = st;
    if (threadIdx.x == 0) (void)xb_add(&bar[XB_XCNT(b.x)], 1u);
    return b;
}
__device__ __forceinline__ void xcd_barrier_complete(unsigned* bar, unsigned x, unsigned& nloc, unsigned& nx) {
    const unsigned G = gridDim.x * gridDim.y * gridDim.z;
    unsigned sum, cnt, mine, sp = 0u;
    for (;;) {
        sum = 0u; cnt = 0u; mine = 0u;
#pragma unroll
        for (unsigned j = 0; j < 16; ++j) { const unsigned c = xb_ld(&bar[XB_XCNT(j)]); sum += c; cnt += (c > 0u) ? 1u : 0u; mine = (j == x) ? c : mine; }
        if (sum == G) break;
        __builtin_amdgcn_s_sleep(1);
        if ((++sp & 255u) == 0u) { if (xb_ld(&bar[XB_TMO])) break; if (sp > XB_SPIN_CAP) { atomicAdd(&bar[XB_TMO], 1u); break; } }
    }
    nloc = mine > 0u ? mine : 1u; nx = cnt > 0u ? cnt : 1u;
}

__device__ __forceinline__ void xcd_barrier(const XcdBarrier& b) {
    asm volatile("s_waitcnt vmcnt(0)" ::: "memory");
    __syncthreads();
    if (threadIdx.x == 0) {
        unsigned* bar = b.bar;
        __builtin_amdgcn_s_waitcnt(0);
        unsigned nloc = b.st[0], nx = b.st[1];
        if (nloc == 0u) { xcd_barrier_complete(bar, b.x, nloc, nx); b.st[0] = nloc; b.st[1] = nx; }
        const unsigned old = xb_add(&bar[XB_XSUB(b.x)], 1u);
        const unsigned gen = old / nloc;
        if (old + 1u == (gen + 1u) * nloc) {
            __builtin_amdgcn_fence(__ATOMIC_RELEASE, "agent");
            asm volatile("s_waitcnt vmcnt(0)" ::: "memory");
            const unsigned og = xb_add(&bar[XB_TOP], 1u);
            const unsigned tg = og / nx;
            if (og + 1u == (tg + 1u) * nx) xb_add(&bar[XB_TOPGEN], 1u);
            else XB_SPIN(xb_ld(&bar[XB_TOPGEN]) == tg, bar);
            __builtin_amdgcn_fence(__ATOMIC_ACQUIRE, "agent");
            xb_add(&bar[XB_XGEN(b.x)], 1u);
            asm volatile("s_waitcnt vmcnt(0)" ::: "memory");
        } else {
            XB_SPIN(xb_ld(&bar[XB_XGEN(b.x)]) == gen, bar);
            __builtin_amdgcn_fence(__ATOMIC_ACQUIRE, "agent");
            asm volatile("s_waitcnt vmcnt(0)" ::: "memory");
        }
    }
    __syncthreads();
}
__device__ __forceinline__ void p0_transpose_item(const float* W, int ldw, int K, bf16* WT, int k0, int nsrc0, int dstrow0, LAS float* scr, int lane) {
#pragma unroll 8
    for (int i = 0; i < 32; ++i) { const int kk = 2 * i + (lane >> 5); scr[kk * 33 + (lane & 31)] = W[(size_t)(k0 + kk) * ldw + nsrc0 + (lane & 31)]; }
    LDS_WAIT(); asm volatile("" ::: "memory");
    const int c = lane & 7;
#pragma unroll
    for (int j = 0; j < 4; ++j) { const int n = (lane >> 3) + 8 * j; const LAS float* s = scr + (8 * c) * 33 + n;
        v4u o; o.x = pk2(s[0 * 33], s[1 * 33]); o.y = pk2(s[2 * 33], s[3 * 33]); o.z = pk2(s[4 * 33], s[5 * 33]); o.w = pk2(s[6 * 33], s[7 * 33]);
        *(GAS v4u*)(WT + (size_t)(dstrow0 + n) * K + k0 + 8 * c) = o; }
    LDS_WAIT(); asm volatile("" ::: "memory");
}
__device__ __forceinline__ int w1_dst_row(int n0) { const int h = n0 / DFF, r = n0 - h * DFF; return 256 * (r / 128) + 128 * h + (r % 128); }

__device__ __forceinline__ void ph_prologue(const float* cvec, const float* ada_w, const float* ada_b, const float* w1a, const float* w2a, const float* win, const float* wout, const float* w1b, const float* w2b,
                                            unsigned char* ws, LAS unsigned char* lds, int tid, int lane, int wave, int G) {
    {
        float* mod = (float*)(ws + WS_MOD);
        LAS float* red = (LAS float*)(lds + 12288);
        for (int it = blockIdx.x; it < 2 * (NMOD / 128); it += G) {
            const int l = it / (NMOD / 128), n0 = (it % (NMOD / 128)) * 128;
            const float* W = ada_w + (size_t)l * DM * NMOD + n0 + 2 * lane;
            float ax = 0.f, ay = 0.f;
#pragma unroll 8
            for (int k = wave * 256; k < wave * 256 + 256; ++k) { const float cv = cvec[k]; const float sc = silu_full(cv); const f32x2 w = *(const f32x2*)(W + (size_t)k * NMOD); ax += sc * w.x; ay += sc * w.y; }
            red[wave * 128 + 2 * lane] = ax; red[wave * 128 + 2 * lane + 1] = ay;
            __syncthreads();
            if (tid < 128) { float s = 0.f;
#pragma unroll
                for (int w = 0; w < 8; ++w) s += red[w * 128 + tid];
                mod[l * NMOD + n0 + tid] = s + ada_b[l * NMOD + n0 + tid]; }
            __syncthreads();
        }
    }
    {
        LAS float* scr = (LAS float*)(lds + wave * 16384);
        const int gw = blockIdx.x * NWAVES + wave, NGW = G * NWAVES;
        constexpr int I1 = (DM / 64) * (N1 / 32), I2 = (DFF / 64) * (DM / 32), I3 = (DM / 64) * (NZ / 32), I4 = (DM / 64) * (DM / 32), IL = 2 * I1 + 2 * I2 + I3 + I4;
        for (int it = gw; it < 2 * IL; it += NGW) {
            const int l = it / IL; int r = it - l * IL;
            if (r < 2 * I1) { const int f = r / I1; r -= f * I1; const int kb = r / (N1 / 32), nb = r % (N1 / 32);
                p0_transpose_item((f ? w1b : w1a) + (size_t)l * DM * N1, N1, DM, (bf16*)(ws + WS_W1T) + (size_t)(l * 2 + f) * N1 * DM, 64 * kb, 32 * nb, w1_dst_row(32 * nb), scr, lane); continue; }
            r -= 2 * I1;
            if (r < 2 * I2) { const int f = r / I2; r -= f * I2; const int kb = r / (DM / 32), nb = r % (DM / 32);
                p0_transpose_item((f ? w2b : w2a) + (size_t)l * DFF * DM, DM, DFF, (bf16*)(ws + WS_W2T) + (size_t)(l * 2 + f) * DM * DFF, 64 * kb, 32 * nb, 32 * nb, scr, lane); continue; }
            r -= 2 * I2;
            if (r < I3) { const int kb = r / (NZ / 32), nb = r % (NZ / 32);
                p0_transpose_item(win + (size_t)l * DM * NIN, NIN, DM, (bf16*)(ws + WS_WINT) + (size_t)l * NZ * DM, 64 * kb, 32 * nb, 32 * nb, scr, lane); continue; }
            r -= I3;
            { const int kb = r / (DM / 32), nb = r % (DM / 32);
                p0_transpose_item(wout + (size_t)l * DM * DM, DM, DM, (bf16*)(ws + WS_WOUTT) + (size_t)l * DM * DM, 64 * kb, 32 * nb, 32 * nb, scr, lane); }
        }
    }
    {
        float* Wg = (float*)(ws + WS_WG);
        for (int i = blockIdx.x * 512 + tid; i < 2 * 8 * DM; i += G * 512) { const int l = i / (8 * DM), e = (i / DM) % 8, k = i % DM; Wg[i] = win[((size_t)l * DM + k) * NIN + NZ + e]; }
    }
}

__device__ __forceinline__ void ph_modulate(const float* x, const float* shift, const float* scale, bf16* Hb, int lane, int wave, int G) {
    f32x4 sc[8], sh[8];
#pragma unroll
    for (int j = 0; j < 8; ++j) { sc[j] = *(const f32x4*)(scale + 4 * lane + 256 * j) + 1.0f; sh[j] = *(const f32x4*)(shift + 4 * lane + 256 * j); }
    const int gw = blockIdx.x * NWAVES + wave, NGW = G * NWAVES;
    for (int m = gw; m < S_; m += NGW) {
        const f32x4* xr = (const f32x4*)(x + (size_t)m * DM) + lane; v2u* o8 = (v2u*)(Hb + (size_t)m * DM) + lane;
#pragma unroll
        for (int j = 0; j < 8; ++j) { const f32x4 h = xr[64 * j] * sc[j] + sh[j]; v2u w; w.x = pk2(h.x, h.y); w.y = pk2(h.z, h.w); o8[64 * j] = w; }
    }
}

__device__ __forceinline__ void ph_ln(const float* Y, float* Xout, const float* g, const float* b, const float* shift, const float* scale, bf16* Hb,
                                      const float* Wg, float* gates, LAS unsigned char* lds, int tid, int lane, int wave, int G) {
    LAS float* WgL = (LAS float*)lds;
    if (Wg) { for (int i = tid; i < 8 * DM / 4; i += 512) ((LAS f32x4*)WgL)[i] = ((const f32x4*)Wg)[i]; __syncthreads(); }
    const int gw = blockIdx.x * NWAVES + wave, NGW = G * NWAVES;
    for (int m = gw; m < S_; m += NGW) {
        const f32x4* yr = (const f32x4*)(Y + (size_t)m * DM) + lane;
        f32x4 v[8]; float s = 0.f;
#pragma unroll
        for (int j = 0; j < 8; ++j) { v[j] = yr[64 * j]; s += (v[j].x + v[j].y) + (v[j].z + v[j].w); }
        const float mean = wave_sum(s) * (1.f / DM); float s2 = 0.f;
#pragma unroll
        for (int j = 0; j < 8; ++j) { v[j] = v[j] - mean; s2 += (v[j].x * v[j].x + v[j].y * v[j].y) + (v[j].z * v[j].z + v[j].w * v[j].w); }
        const float rstd = 1.f / sqrtf(wave_sum(s2) * (1.f / DM) + LN_EPS);
        f32x4* xo = (f32x4*)(Xout + (size_t)m * DM) + lane;
#pragma unroll
        for (int j = 0; j < 8; ++j) { v[j] = v[j] * rstd * *(const f32x4*)(g + 4 * lane + 256 * j) + *(const f32x4*)(b + 4 * lane + 256 * j); xo[64 * j] = v[j]; }
        if (scale) {
            v2u* o8 = (v2u*)(Hb + (size_t)m * DM) + lane;
#pragma unroll
            for (int j = 0; j < 8; ++j) { v[j] = v[j] * (*(const f32x4*)(scale + 4 * lane + 256 * j) + 1.0f) + *(const f32x4*)(shift + 4 * lane + 256 * j); v2u w; w.x = pk2(v[j].x, v[j].y); w.y = pk2(v[j].z, v[j].w); o8[64 * j] = w; }
            if (Wg) {
#pragma unroll
                for (int e = 0; e < 8; ++e) { float p = 0.f;
#pragma unroll
                    for (int j = 0; j < 8; ++j) { const f32x4 w = *(const LAS f32x4*)(WgL + e * DM + 4 * lane + 256 * j); p += (v[j].x * w.x + v[j].y * w.y) + (v[j].z * w.z + v[j].w * w.w); }
                    p = wave_sum(p); if (lane == 0) gates[(size_t)m * 8 + e] = p; }
            }
        }
    }
    if (Wg) __syncthreads();
}

__device__ __forceinline__ void ph_prep_naive(const bf16* Z3, const float* cw, const float* cb, const float* gates, const float* gb, float* QKC, double* Bc,
                                              LAS unsigned char* lds, int tid, int G) {
    for (size_t i = (size_t)blockIdx.x * 512 + tid; i < (size_t)S_ * 1024; i += (size_t)G * 512) {
        const int t = (int)(i >> 10), c = (int)(i & 1023); float a = cb[c];
#pragma unroll
        for (int k = 0; k < 4; ++k) { const int tt = t - 3 + k; if (tt >= 0) a += cw[k * 1024 + c] * bf1(Z3[(size_t)tt * 1024 + c]); }
        a = silu_full(a); if (c < 512) a *= QSCALE; QKC[i] = a;
    }
    if (blockIdx.x < 4) {
        const int hd = blockIdx.x; LAS double* part = (LAS double*)lds; const float fb = gb[4 + hd];
        double s = 0.0;
        for (int t = tid * 32; t < tid * 32 + 32; ++t) s += (double)(-softplus_f(-(gates[(size_t)t * 8 + 4 + hd] + fb)));
        part[tid] = s; __syncthreads();
        double pre = 0.0; for (int i = 0; i < tid; ++i) pre += part[i];
        for (int t = tid * 32; t < tid * 32 + 32; ++t) { pre += (double)(-softplus_f(-(gates[(size_t)t * 8 + 4 + hd] + fb))); Bc[(size_t)hd * S_ + t] = pre; }
        __syncthreads();
    }
}

__device__ __forceinline__ void ph_mix_naive(const bf16* Z, const float* QKC, const double* Bc, const float* gates, const float* gb, const float* ng, bf16* YC, int lane, int wave, int G) {
    const int gw = blockIdx.x * NWAVES + wave, NGW = G * NWAVES;
    const bf16 *Z4 = Z + 4 * ZT, *Z5 = Z + 5 * ZT;
    for (int it = gw; it < S_ * 4; it += NGW) {
        const int t = it >> 2, hd = it & 3; const double Bt = Bc[(size_t)hd * S_ + t]; const float gbi = gb[hd];
        const f32x2 q = *(const f32x2*)(QKC + (size_t)t * 1024 + hd * 128 + 2 * lane);
        float den = 0.f, n0 = 0.f, n1 = 0.f, n2 = 0.f, n3 = 0.f;
        for (int s = t; s >= 0; s -= 4) {
            float p[4], wl[4];
#pragma unroll
            for (int j = 0; j < 4; ++j) { const int sj = (s - j) > 0 ? (s - j) : 0; const f32x2 k = *(const f32x2*)(QKC + (size_t)sj * 1024 + 512 + hd * 128 + 2 * lane); p[j] = q.x * k.x + q.y * k.y;
                wl[j] = (float)(Bt - Bc[(size_t)hd * S_ + sj]) + gates[(size_t)sj * 8 + hd] + gbi; }
#pragma unroll
            for (int o = 1; o < 64; o <<= 1) {
#pragma unroll
                for (int j = 0; j < 4; ++j) p[j] += __shfl_xor(p[j], o); }
#pragma unroll
            for (int j = 0; j < 4; ++j) if (s - j >= 0) { const float c = __expf(wl[j]) * p[j]; den += c;
                const v2u vv = *(const v2u*)(Z4 + (size_t)(s - j) * 1024 + hd * 256 + 4 * lane); n0 += c * bflo(vv.x); n1 += c * bfhi(vv.x); n2 += c * bflo(vv.y); n3 += c * bfhi(vv.y); }
            const int sl = (s - 3) > 0 ? (s - 3) : 0;
            if ((float)(Bt - Bc[(size_t)hd * S_ + sl]) < -150.f) break;
        }
        const float rd = 1.f / fmaxf(fabsf(den), 1.f); n0 *= rd; n1 *= rd; n2 *= rd; n3 *= rd;
        const float mean = wave_sum((n0 + n1) + (n2 + n3)) * (1.f / 256.f); n0 -= mean; n1 -= mean; n2 -= mean; n3 -= mean;
        const float var = wave_sum((n0 * n0 + n1 * n1) + (n2 * n2 + n3 * n3)) * (1.f / 256.f), rstd = 1.f / sqrtf(var + LN_EPS);
        const f32x4 gg = *(const f32x4*)(ng + 1024 + hd * 256 + 4 * lane); const v2u og = *(const v2u*)(Z5 + (size_t)t * 1024 + hd * 256 + 4 * lane);
        v2u w; w.x = pk2(n0 * rstd * gg.x * sigmoid_f(bflo(og.x)), n1 * rstd * gg.y * sigmoid_f(bfhi(og.x))); w.y = pk2(n2 * rstd * gg.z * sigmoid_f(bflo(og.y)), n3 * rstd * gg.w * sigmoid_f(bfhi(og.y)));
        *(v2u*)(YC + (size_t)t * DM + 1024 + hd * 256 + 4 * lane) = w;
    }
}
namespace sba {
typedef short bf16x8 __attribute__((ext_vector_type(8)));
typedef short s16x4 __attribute__((ext_vector_type(4)));
typedef float f32x16 __attribute__((ext_vector_type(16)));
constexpr int LDS_V = 0, LDS_K = 32768, TILE_B = 16384, KROW = 272, KTILE_B = 64 * KROW, LDS_Q = LDS_K + 2 * KTILE_B, QWAVE_B = 32 * KROW, LDS_FLAG = LDS_Q + 8 * QWAVE_B;
constexpr float STICK_DEAD = -160.0f;
__device__ __forceinline__ int crow(int r, int hi) { return (r & 3) + 8 * (r >> 2) + 4 * hi; }
__device__ __forceinline__ unsigned cvtpk(float lo, float hi) { unsigned r; asm volatile("v_cvt_pk_bf16_f32 %0, %1, %2" : "=v"(r) : "v"(lo), "v"(hi)); return r; }
__device__ __forceinline__ int v_st(int k, int c) { return ((k >> 3) * 4 + (c >> 5)) * 512 + ((k & 7) * 32 + (c & 31)) * 2; }
__device__ __forceinline__ int v_rd_base(int lane) { return ((lane & 3) << 3) | (((lane >> 2) & 3) << 6) | (((lane >> 4) & 1) << 5) | (((lane >> 5) & 1) << 8); }
constexpr int v_rd_off(int d0, int ks, int half) { return d0 * 512 + ks * 4096 + half * 2048; }
template <int OFF> __device__ __forceinline__ s16x4 tr_read(int vb) { s16x4 r; asm volatile("ds_read_b64_tr_b16 %0, %1 offset:%2" : "=&v"(r) : "v"(vb), "i"(OFF) : "memory"); return r; }
#define SBA_PK(L, H) (bf16x8){L[0], L[1], L[2], L[3], H[0], H[1], H[2], H[3]}
template <int D0> __device__ __forceinline__ void pv_one(f32x16& od, int vb, bf16x8 pa0, bf16x8 pa1, bf16x8 pa2, bf16x8 pa3) {
    const s16x4 l0 = tr_read<v_rd_off(D0, 0, 0)>(vb), h0 = tr_read<v_rd_off(D0, 0, 1)>(vb), l1 = tr_read<v_rd_off(D0, 1, 0)>(vb), h1 = tr_read<v_rd_off(D0, 1, 1)>(vb);
    const s16x4 l2 = tr_read<v_rd_off(D0, 2, 0)>(vb), h2 = tr_read<v_rd_off(D0, 2, 1)>(vb), l3 = tr_read<v_rd_off(D0, 3, 0)>(vb), h3 = tr_read<v_rd_off(D0, 3, 1)>(vb);
    asm volatile("s_waitcnt lgkmcnt(0)" ::: "memory"); __builtin_amdgcn_sched_barrier(0);
    od = __builtin_amdgcn_mfma_f32_32x32x16_bf16(SBA_PK(l0, h0), pa0, od, 0, 0, 0);
    od = __builtin_amdgcn_mfma_f32_32x32x16_bf16(SBA_PK(l1, h1), pa1, od, 0, 0, 0);
    od = __builtin_amdgcn_mfma_f32_32x32x16_bf16(SBA_PK(l2, h2), pa2, od, 0, 0, 0);
    od = __builtin_amdgcn_mfma_f32_32x32x16_bf16(SBA_PK(l3, h3), pa3, od, 0, 0, 0);
}
__device__ __forceinline__ void half_tile(const f32x16& X, int kb, int q_abs, int hi, float& R, bf16x8& f0, bf16x8& f1) {
    float L[16], a[16];
#pragma unroll
    for (int r = 0; r < 16; ++r) { const float z = X[r]; const float e = __builtin_amdgcn_exp2f(-fabsf(z)); const float sp = fmaxf(z, 0.f) + __builtin_amdgcn_logf(1.0f + e);
        L[r] = (kb + crow(r, hi) < q_abs) ? -sp : 0.f; }
    float G[4], P[4], T[4];
#pragma unroll
    for (int g = 0; g < 4; ++g) { G[g] = (L[4 * g] + L[4 * g + 1]) + (L[4 * g + 2] + L[4 * g + 3]); P[g] = __shfl_xor(G[g], 32); }
    const float SG2 = G[3], SG1 = SG2 + G[2], SG0 = SG1 + G[1];
    const float SP3 = P[3], SP2 = SP3 + P[2], SP1 = SP2 + P[1], SP0 = SP1 + P[0];
    T[3] = R + (hi ? 0.f : SP3); T[2] = R + SG2 + (hi ? SP3 : SP2); T[1] = R + SG1 + (hi ? SP2 : SP1); T[0] = R + SG0 + (hi ? SP1 : SP0);
#pragma unroll
    for (int g = 0; g < 4; ++g) { const float s3 = T[g], s2 = s3 + L[4 * g + 3], s1 = s2 + L[4 * g + 2], s0 = s1 + L[4 * g + 1];
        a[4 * g + 3] = __builtin_amdgcn_exp2f(X[4 * g + 3] + L[4 * g + 3] + s3); a[4 * g + 2] = __builtin_amdgcn_exp2f(X[4 * g + 2] + L[4 * g + 2] + s2);
        a[4 * g + 1] = __builtin_amdgcn_exp2f(X[4 * g + 1] + L[4 * g + 1] + s1); a[4 * g + 0] = __builtin_amdgcn_exp2f(X[4 * g + 0] + L[4 * g + 0] + s0); }
#pragma unroll
    for (int r = 0; r < 16; ++r) a[r] = (kb + crow(r, hi) < q_abs) ? a[r] : 0.f;
    R += (SG0 + G[0]) + SP0;
    typedef unsigned u32x4v __attribute__((ext_vector_type(4)));
    u32x4v w0 = {cvtpk(a[0], a[1]), cvtpk(a[2], a[3]), cvtpk(a[4], a[5]), cvtpk(a[6], a[7])}, w1 = {cvtpk(a[8], a[9]), cvtpk(a[10], a[11]), cvtpk(a[12], a[13]), cvtpk(a[14], a[15])};
    f0 = __builtin_bit_cast(bf16x8, w0); f1 = __builtin_bit_cast(bf16x8, w1);
}
__device__ __forceinline__ void tile_compute(LAS unsigned char* lds, int buf, const LAS unsigned char* Qs, f32x16 (&o)[4], float& R, int key0, int q_abs, int r32, int hi, int lane) {
    const LAS unsigned char* Ks = lds + LDS_K + buf * KTILE_B + r32 * KROW + hi * 16;
    bf16x8 pa0, pa1, pa2, pa3;
    {
        f32x16 p1 = {};
#pragma unroll
        for (int d0 = 0; d0 < 8; ++d0) { const bf16x8 b1 = *(const LAS bf16x8*)(Ks + 32 * KROW + d0 * 32); const bf16x8 qf = *(const LAS bf16x8*)(Qs + d0 * 32); p1 = __builtin_amdgcn_mfma_f32_32x32x16_bf16(b1, qf, p1, 0, 0, 0); }
        __builtin_amdgcn_sched_barrier(0);
        half_tile(p1, key0 + 32, q_abs, hi, R, pa2, pa3);
        __builtin_amdgcn_sched_barrier(0);
    }
    {
        f32x16 p0 = {};
#pragma unroll
        for (int d0 = 0; d0 < 8; ++d0) { const bf16x8 b0 = *(const LAS bf16x8*)(Ks + d0 * 32); const bf16x8 qf = *(const LAS bf16x8*)(Qs + d0 * 32); p0 = __builtin_amdgcn_mfma_f32_32x32x16_bf16(b0, qf, p0, 0, 0, 0); }
        __builtin_amdgcn_sched_barrier(0);
        half_tile(p0, key0, q_abs, hi, R, pa0, pa1);
        __builtin_amdgcn_sched_barrier(0);
    }
    const int vb = (int)(uintptr_t)(lds + LDS_V + buf * TILE_B) + v_rd_base(lane);
    pv_one<0>(o[0], vb, pa0, pa1, pa2, pa3); pv_one<1>(o[1], vb, pa0, pa1, pa2, pa3); pv_one<2>(o[2], vb, pa0, pa1, pa2, pa3); pv_one<3>(o[3], vb, pa0, pa1, pa2, pa3);
}
__device__ __forceinline__ void unit(int hd, int qb, const bf16* Q, const bf16* K, const bf16* V, const float* ng, bf16* Y, LAS unsigned char* lds, int tid) {
    const int wid = __builtin_amdgcn_readfirstlane(tid >> 6), lane = tid & 63, r32 = lane & 31, hi = lane >> 5;
    const int t0 = qb * 256, qrow0 = t0 + wid * 32, q_abs = qrow0 + r32;
    LAS unsigned char* Qs = lds + LDS_Q + wid * QWAVE_B + r32 * KROW + hi * 16;
    { const bf16* Qw = Q + (size_t)q_abs * 1024 + hd * 128 + hi * 8;
#pragma unroll
      for (int d0 = 0; d0 < 8; ++d0) *(LAS bf16x8*)(Qs + d0 * 32) = *(const bf16x8*)(Qw + d0 * 16); }
    f32x16 o[4] = {}; float R = 0.f;
    const int sr = tid >> 4, sc = (tid & 15) * 8, vst0 = v_st(sr, sc), vst1 = v_st(32 + sr, sc), kst0 = sr * KROW + sc * 2, kst1 = (32 + sr) * KROW + sc * 2;
    const bf16* Kh = K + hd * 128 + sc; const bf16* Vh = V + hd * 128 + sc;
    bf16x8 ks0, ks1, vs0, vs1;
#define SBA_SLOAD(k0) do { ks0 = *(const bf16x8*)(Kh + (size_t)((k0) + sr) * 1024); ks1 = *(const bf16x8*)(Kh + (size_t)((k0) + 32 + sr) * 1024); \
        vs0 = *(const bf16x8*)(Vh + (size_t)((k0) + sr) * 1024); vs1 = *(const bf16x8*)(Vh + (size_t)((k0) + 32 + sr) * 1024); } while (0)
#define SBA_SWRITE(b) do { *(LAS bf16x8*)(lds + LDS_K + (b) * KTILE_B + kst0) = ks0; *(LAS bf16x8*)(lds + LDS_K + (b) * KTILE_B + kst1) = ks1; \
        *(LAS bf16x8*)(lds + LDS_V + (b) * TILE_B + vst0) = vs0; *(LAS bf16x8*)(lds + LDS_V + (b) * TILE_B + vst1) = vs1; } while (0)
    volatile LAS int* flags = (volatile LAS int*)(lds + LDS_FLAG);
    int jt = (t0 + 255) >> 6, buf = 0; bool dead = false;
    SBA_SLOAD(jt * 64);
    for (;;) {
        SBA_SWRITE(buf); if (lane == 0) flags[buf * 8 + wid] = dead ? 1 : 0;
        __syncthreads();
        int ndead = 0;
#pragma unroll
        for (int w = 0; w < 8; ++w) ndead += flags[buf * 8 + w];
        if (ndead == 8) break;
        if (jt > 0) SBA_SLOAD((jt - 1) * 64);
        const int key0 = jt * 64;
        if (!dead && key0 <= qrow0 + 30) {
            tile_compute(lds, buf, Qs, o, R, key0, (key0 + 63 >= qrow0) ? q_abs : 0x7fffffff, r32, hi, lane);
            dead = __all(R < STICK_DEAD) != 0;
        }
        if (jt == 0) break;
        --jt; buf ^= 1;
    }
#undef SBA_SLOAD
#undef SBA_SWRITE
    float s = 0.f;
#pragma unroll
    for (int d0 = 0; d0 < 4; ++d0)
#pragma unroll
        for (int r = 0; r < 16; ++r) s += o[d0][r];
    s += __shfl_xor(s, 32);
    const float mean = s * (1.f / 128.f); float q2 = 0.f;
#pragma unroll
    for (int d0 = 0; d0 < 4; ++d0)
#pragma unroll
        for (int r = 0; r < 16; ++r) { o[d0][r] -= mean; q2 += o[d0][r] * o[d0][r]; }
    q2 += __shfl_xor(q2, 32);
    const float rstd = 1.f / sqrtf(q2 * (1.f / 128.f) + LN_EPS);
    bf16* Yq = Y + (size_t)q_abs * DM + hd * 128 + 4 * hi;
#pragma unroll
    for (int d0 = 0; d0 < 4; ++d0)
#pragma unroll
        for (int g = 0; g < 4; ++g) { const f32x4 gg = *(const f32x4*)(ng + 32 * d0 + 8 * g + 4 * hi);
            v2u w; w.x = cvtpk(o[d0][4 * g] * rstd * gg.x, o[d0][4 * g + 1] * rstd * gg.y); w.y = cvtpk(o[d0][4 * g + 2] * rstd * gg.z, o[d0][4 * g + 3] * rstd * gg.w);
            *(v2u*)(Yq + 32 * d0 + 8 * g) = w; }
    __syncthreads();
}
__device__ __forceinline__ void phase(const bf16* Z, const float* ng, bf16* Y, LAS unsigned char* lds, int tid, int G) {
    for (int u = blockIdx.x; u < 8 * (S_ / 256); u += G) { const int hd = u / (S_ / 256), qb = u % (S_ / 256);
        unit(hd, qb, Z, Z + ZT, Z + 2 * ZT, ng + hd * 128, Y, lds, tid); }
}
}
namespace mls {
typedef short bf16x8 __attribute__((ext_vector_type(8)));
typedef short s16x4 __attribute__((ext_vector_type(4)));
typedef float f32x16 __attribute__((ext_vector_type(16)));
constexpr int SPAN = 256, NSPAN = S_ / SPAN, KROW = 272;
constexpr float L2E = 1.4426950408889634f;
using sba::tr_read; using sba::v_rd_off; using sba::v_rd_base; using sba::v_st; using sba::crow; using sba::cvtpk;
constexpr int L_V = 0, L_K = 32768, L_B = L_K + 64 * KROW, L_C = L_B + 1024, L_N = L_C + 1024, L_X = L_N + 512, L_S = L_X + 64;

template <int KS> __device__ __forceinline__ void a_step(f32x16 (&acc)[4], int vbA, int vbB) {
    const s16x4 al = tr_read<v_rd_off(0, KS, 0)>(vbA), ah = tr_read<v_rd_off(0, KS, 1)>(vbA);
    const s16x4 b0l = tr_read<v_rd_off(0, KS, 0)>(vbB), b0h = tr_read<v_rd_off(0, KS, 1)>(vbB), b1l = tr_read<v_rd_off(1, KS, 0)>(vbB), b1h = tr_read<v_rd_off(1, KS, 1)>(vbB);
    const s16x4 b2l = tr_read<v_rd_off(2, KS, 0)>(vbB), b2h = tr_read<v_rd_off(2, KS, 1)>(vbB), b3l = tr_read<v_rd_off(3, KS, 0)>(vbB), b3h = tr_read<v_rd_off(3, KS, 1)>(vbB);
    asm volatile("s_waitcnt lgkmcnt(0)" ::: "memory"); __builtin_amdgcn_sched_barrier(0);
    const bf16x8 A = SBA_PK(al, ah);
    acc[0] = __builtin_amdgcn_mfma_f32_32x32x16_bf16(A, SBA_PK(b0l, b0h), acc[0], 0, 0, 0); acc[1] = __builtin_amdgcn_mfma_f32_32x32x16_bf16(A, SBA_PK(b1l, b1h), acc[1], 0, 0, 0);
    acc[2] = __builtin_amdgcn_mfma_f32_32x32x16_bf16(A, SBA_PK(b2l, b2h), acc[2], 0, 0, 0); acc[3] = __builtin_amdgcn_mfma_f32_32x32x16_bf16(A, SBA_PK(b3l, b3h), acc[3], 0, 0, 0);
}
__device__ __forceinline__ void phaseA_item(int hd, int j, const bf16* Z3, const bf16* Z4, const float* cw, const float* cb, const float* graw, const float* gb,
                                            bf16* QKT, float* BL, float* LI, float* BTOT, float* DC, float* DN, LAS unsigned char* lds, int tid) {
    const int wid = __builtin_amdgcn_readfirstlane(tid >> 6), lane = tid & 63, t0 = j * SPAN;
    LAS float* bL = (LAS float*)(lds + L_B); LAS float* cL = (LAS float*)(lds + L_C); LAS float* dnL = (LAS float*)(lds + L_N); LAS float* xL = (LAS float*)(lds + L_X);
    if (tid < 128) dnL[tid] = 0.f;
    if (wid == 0) {
        const float fb = gb[4 + hd], ib = gb[hd]; float c[4], li[4];
#pragma unroll
        for (int e = 0; e < 4; ++e) { const int t = t0 + 4 * lane + e; const float lf = -softplus_f(-(graw[(size_t)t * 8 + 4 + hd] + fb)) * L2E; li[e] = (graw[(size_t)t * 8 + hd] + ib) * L2E; c[e] = lf + (e ? c[e - 1] : 0.f); }
        float inc = c[3];
#pragma unroll
        for (int o = 1; o < 64; o <<= 1) { const float v = __shfl_up(inc, o); if (lane >= o) inc += v; }
        const float pre = inc - c[3];
#pragma unroll
        for (int e = 0; e < 4; ++e) { const float b = pre + c[e]; bL[4 * lane + e] = b; cL[4 * lane + e] = li[e]; BL[(size_t)hd * S_ + t0 + 4 * lane + e] = b; LI[(size_t)hd * S_ + t0 + 4 * lane + e] = li[e]; }
        if (lane == 63) { xL[0] = inc; BTOT[hd * NSPAN + j] = inc; }
    }
    const int chunk = tid & 31, part = chunk >> 4, ccol = part * 512 + hd * 128 + 8 * (chunk & 15);
    float wt[4][8], wb[8];
#pragma unroll
    for (int e = 0; e < 8; ++e) { wb[e] = cb[ccol + e];
#pragma unroll
        for (int k = 0; k < 4; ++k) wt[k][e] = cw[k * 1024 + ccol + e]; }
    f32x16 acc[4] = {};
    __syncthreads();
    const float Btot = xL[0];
    const int vbA = (int)(uintptr_t)(lds + L_V + (wid >> 2) * 16384 + (wid & 3) * 512) + v_rd_base(lane), vbB = (int)(uintptr_t)(lds + L_K) + v_rd_base(lane);
    for (int ch = 0; ch < 4; ++ch) {
#pragma unroll
        for (int i = 0; i < 4; ++i) {
            const int row = (tid >> 5) + 16 * i, tl = ch * 64 + row, t = t0 + tl;
            *(LAS bf16x8*)(lds + L_V + part * 16384 + v_st(row, 8 * (chunk & 15))) = *(const bf16x8*)(Z4 + (size_t)t * 1024 + hd * 256 + 8 * chunk);
            float a[8];
#pragma unroll
            for (int e = 0; e < 8; ++e) a[e] = wb[e];
#pragma unroll
            for (int k = 0; k < 4; ++k) { const int tt = t - 3 + k; if (tt >= 0) { const v4u raw = *(const v4u*)(Z3 + (size_t)tt * 1024 + ccol);
                a[0] += wt[k][0] * bflo(raw.x); a[1] += wt[k][1] * bfhi(raw.x); a[2] += wt[k][2] * bflo(raw.y); a[3] += wt[k][3] * bfhi(raw.y);
                a[4] += wt[k][4] * bflo(raw.z); a[5] += wt[k][5] * bfhi(raw.z); a[6] += wt[k][6] * bflo(raw.w); a[7] += wt[k][7] * bfhi(raw.w); } }
#pragma unroll
            for (int e = 0; e < 8; ++e) a[e] = silu_full(a[e]);
            if (part == 0) {
#pragma unroll
                for (int e = 0; e < 8; ++e) a[e] *= QSCALE;
            }
            v4u pk; pk.x = cvtpk(a[0], a[1]); pk.y = cvtpk(a[2], a[3]); pk.z = cvtpk(a[4], a[5]); pk.w = cvtpk(a[6], a[7]);
            *(v4u*)(QKT + (size_t)t * 1024 + ccol) = pk;
            if (part == 1) {
                const float w = __builtin_amdgcn_exp2f(Btot - bL[tl] + cL[tl]);
#pragma unroll
                for (int e = 0; e < 8; ++e) { a[e] *= w; atomicAdd((float*)&dnL[8 * (chunk & 15) + e], a[e]); }
                v4u pw; pw.x = cvtpk(a[0], a[1]); pw.y = cvtpk(a[2], a[3]); pw.z = cvtpk(a[4], a[5]); pw.w = cvtpk(a[6], a[7]);
                *(LAS v4u*)(lds + L_K + v_st(row, 8 * (chunk & 15))) = pw;
            }
        }
        __syncthreads();
        a_step<0>(acc, vbA, vbB); a_step<1>(acc, vbA, vbB); a_step<2>(acc, vbA, vbB); a_step<3>(acc, vbA, vbB);
        __syncthreads();
    }
    { float* o = DC + ((size_t)(hd * NSPAN + j) * 256 + 32 * wid) * 128 + (lane & 31); const int hi = lane >> 5;
#pragma unroll
      for (int n0 = 0; n0 < 4; ++n0)
#pragma unroll
          for (int r = 0; r < 16; ++r) o[(size_t)crow(r, hi) * 128 + 32 * n0] = acc[n0][r]; }
    if (tid < 128) DN[(size_t)(hd * NSPAN + j) * 128 + tid] = dnL[tid];
    __syncthreads();
}

__device__ __forceinline__ void phaseS(const float* BTOT, const float* DC, const float* DN, bf16* CS, float* NSS, int tid, int G) {
    const int g = blockIdx.x * 512 + tid;
    if (g < 4 * 16384) {
        const int hd = g >> 14, p = g & 16383; float c0 = 0.f, c1 = 0.f;
        const f32x2* src = (const f32x2*)(DC + (size_t)hd * NSPAN * 32768) + p; unsigned* dst = (unsigned*)(CS + (size_t)hd * NSPAN * 32768) + p;
#pragma unroll 8
        for (int j = 0; j < NSPAN; ++j) { dst[(size_t)j * 16384] = cvtpk(c0, c1); const float d = __builtin_amdgcn_exp2f(BTOT[hd * NSPAN + j]); const f32x2 x = src[(size_t)j * 16384]; c0 = c0 * d + x.x; c1 = c1 * d + x.y; }
    } else if (g < 4 * 16384 + 512) {
        const int q = g - 4 * 16384, hd = q >> 7, dk = q & 127; float c = 0.f;
        for (int j = 0; j < NSPAN; ++j) { NSS[(size_t)(hd * NSPAN + j) * 128 + dk] = c; c = c * __builtin_amdgcn_exp2f(BTOT[hd * NSPAN + j]) + DN[(size_t)(hd * NSPAN + j) * 128 + dk]; }
    }
    (void)G;
}

__device__ __forceinline__ void d_half(const f32x16& X, int kb, int qlim, float bq, const LAS float* cL, int hi, float& den, bf16x8& f0, bf16x8& f1) {
    float a[16];
#pragma unroll
    for (int r = 0; r < 16; ++r) { const int s = kb + crow(r, hi); const float w = __builtin_amdgcn_exp2f(bq + cL[s]); a[r] = (s <= qlim) ? X[r] * w : 0.f; den += a[r]; }
    typedef unsigned u32x4v __attribute__((ext_vector_type(4)));
    u32x4v w0 = {cvtpk(a[0], a[1]), cvtpk(a[2], a[3]), cvtpk(a[4], a[5]), cvtpk(a[6], a[7])}, w1 = {cvtpk(a[8], a[9]), cvtpk(a[10], a[11]), cvtpk(a[12], a[13]), cvtpk(a[14], a[15])};
    f0 = __builtin_bit_cast(bf16x8, w0); f1 = __builtin_bit_cast(bf16x8, w1);
}
template <int DT> __device__ __forceinline__ void d_pv(f32x16& od, int vb, bf16x8 pa0, bf16x8 pa1, bf16x8 pa2, bf16x8 pa3) {
    const s16x4 l0 = tr_read<v_rd_off(DT, 0, 0)>(vb), h0 = tr_read<v_rd_off(DT, 0, 1)>(vb), l1 = tr_read<v_rd_off(DT, 1, 0)>(vb), h1 = tr_read<v_rd_off(DT, 1, 1)>(vb);
    const s16x4 l2 = tr_read<v_rd_off(DT, 2, 0)>(vb), h2 = tr_read<v_rd_off(DT, 2, 1)>(vb), l3 = tr_read<v_rd_off(DT, 3, 0)>(vb), h3 = tr_read<v_rd_off(DT, 3, 1)>(vb);
    asm volatile("s_waitcnt lgkmcnt(0)" ::: "memory"); __builtin_amdgcn_sched_barrier(0);
    od = __builtin_amdgcn_mfma_f32_32x32x16_bf16(SBA_PK(l0, h0), pa0, od, 0, 0, 0);
    od = __builtin_amdgcn_mfma_f32_32x32x16_bf16(SBA_PK(l1, h1), pa1, od, 0, 0, 0);
    od = __builtin_amdgcn_mfma_f32_32x32x16_bf16(SBA_PK(l2, h2), pa2, od, 0, 0, 0);
    od = __builtin_amdgcn_mfma_f32_32x32x16_bf16(SBA_PK(l3, h3), pa3, od, 0, 0, 0);
}
__device__ __forceinline__ void phaseD_item(int hd, int j, int ib, const bf16* QKT, const bf16* Z4, const bf16* Z5, const float* BL, const float* LI, const bf16* CS, const float* NSS,
                                            const float* ng, bf16* Y, LAS unsigned char* lds, int tid) {
    const int wid = __builtin_amdgcn_readfirstlane(tid >> 6), lane = tid & 63, r32 = lane & 31, hi = lane >> 5, wq = wid >> 2, wv = wid & 3;
    const int t0 = j * SPAN, ql = 64 * ib + 32 * wq + r32, q_abs = t0 + ql;
    LAS float* bL = (LAS float*)(lds + L_B); LAS float* cL = (LAS float*)(lds + L_C); LAS float* nL = (LAS float*)(lds + L_N); LAS float* sL = (LAS float*)(lds + L_S);
    if (tid < 256) { const float b = BL[(size_t)hd * S_ + t0 + tid]; bL[tid] = b; cL[tid] = LI[(size_t)hd * S_ + t0 + tid] - b; }
    if (tid < 128) nL[tid] = NSS[(size_t)(hd * NSPAN + j) * 128 + tid];
    bf16x8 qr[8];
    { const bf16* Qw = QKT + (size_t)q_abs * 1024 + hd * 128 + hi * 8;
#pragma unroll
      for (int d0 = 0; d0 < 8; ++d0) qr[d0] = *(const bf16x8*)(Qw + d0 * 16); }
    f32x16 o[2] = {};
    { const bf16* Cw = CS + ((size_t)(hd * NSPAN + j) * 256 + 64 * wv + r32) * 128 + hi * 8;
#pragma unroll
      for (int dt = 0; dt < 2; ++dt)
#pragma unroll
          for (int d0 = 0; d0 < 8; ++d0) { const bf16x8 A = *(const bf16x8*)(Cw + (size_t)dt * 32 * 128 + d0 * 16); o[dt] = __builtin_amdgcn_mfma_f32_32x32x16_bf16(A, qr[d0], o[dt], 0, 0, 0); } }
    __syncthreads();
    const float bq = bL[ql], gq = __builtin_amdgcn_exp2f(bq);
    float den = 0.f;
#pragma unroll
    for (int d0 = 0; d0 < 8; ++d0) { const f32x4 n0 = *(const LAS f32x4*)(nL + 16 * d0 + 8 * hi), n1 = *(const LAS f32x4*)(nL + 16 * d0 + 8 * hi + 4); const bf16x8 q = qr[d0];
        den += bf1((bf16)q[0]) * n0.x + bf1((bf16)q[1]) * n0.y + bf1((bf16)q[2]) * n0.z + bf1((bf16)q[3]) * n0.w + bf1((bf16)q[4]) * n1.x + bf1((bf16)q[5]) * n1.y + bf1((bf16)q[6]) * n1.z + bf1((bf16)q[7]) * n1.w; }
    den *= gq;
#pragma unroll
    for (int dt = 0; dt < 2; ++dt)
#pragma unroll
        for (int r = 0; r < 16; ++r) o[dt][r] *= gq;
    const int vb = (int)(uintptr_t)(lds + L_V + (wv >> 1) * 16384 + (wv & 1) * 1024) + v_rd_base(lane);
    const LAS unsigned char* Ks = lds + L_K + r32 * KROW + hi * 16;
    for (int kt = 0; kt <= ib; ++kt) {
        if (kt) __syncthreads();
#pragma unroll
        for (int i = 0; i < 4; ++i) { const int p = tid + 512 * i, row = p >> 5, chunk = p & 31, t = t0 + 64 * kt + row;
            *(LAS bf16x8*)(lds + L_V + (chunk >> 4) * 16384 + v_st(row, 8 * (chunk & 15))) = *(const bf16x8*)(Z4 + (size_t)t * 1024 + hd * 256 + 8 * chunk);
            if (i < 2) { const int p2 = tid + 512 * i, row2 = p2 >> 4, c2 = p2 & 15; *(LAS bf16x8*)(lds + L_K + row2 * KROW + c2 * 16) = *(const bf16x8*)(QKT + (size_t)(t0 + 64 * kt + row2) * 1024 + 512 + hd * 128 + 8 * c2); } }
        __syncthreads();
        const int qlim = (kt == ib) ? ql : 0x7fffffff;
        bf16x8 pa0, pa1, pa2, pa3;
        { f32x16 p1 = {};
#pragma unroll
          for (int d0 = 0; d0 < 8; ++d0) { const bf16x8 b1 = *(const LAS bf16x8*)(Ks + 32 * KROW + d0 * 32); p1 = __builtin_amdgcn_mfma_f32_32x32x16_bf16(b1, qr[d0], p1, 0, 0, 0); }
          d_half(p1, 64 * kt + 32, qlim, bq, cL, hi, den, pa2, pa3); }
        { f32x16 p0 = {};
#pragma unroll
          for (int d0 = 0; d0 < 8; ++d0) { const bf16x8 b0 = *(const LAS bf16x8*)(Ks + d0 * 32); p0 = __builtin_amdgcn_mfma_f32_32x32x16_bf16(b0, qr[d0], p0, 0, 0, 0); }
          d_half(p0, 64 * kt, qlim, bq, cL, hi, den, pa0, pa1); }
        d_pv<0>(o[0], vb, pa0, pa1, pa2, pa3); d_pv<1>(o[1], vb, pa0, pa1, pa2, pa3);
    }
    den += __shfl_xor(den, 32);
    const float rd = 1.f / fmaxf(fabsf(den), 1.f);
    float s1 = 0.f, s2 = 0.f;
#pragma unroll
    for (int dt = 0; dt < 2; ++dt)
#pragma unroll
        for (int r = 0; r < 16; ++r) { o[dt][r] *= rd; s1 += o[dt][r]; s2 += o[dt][r] * o[dt][r]; }
    s1 += __shfl_xor(s1, 32); s2 += __shfl_xor(s2, 32);
    if (hi == 0) { sL[((wq * 4 + wv) * 32 + r32) * 2] = s1; sL[((wq * 4 + wv) * 32 + r32) * 2 + 1] = s2; }
    __syncthreads();
    float t1 = 0.f, t2 = 0.f;
#pragma unroll
    for (int w = 0; w < 4; ++w) { t1 += sL[((wq * 4 + w) * 32 + r32) * 2]; t2 += sL[((wq * 4 + w) * 32 + r32) * 2 + 1]; }
    const float mean = t1 * (1.f / 256.f), var = fmaxf(t2 * (1.f / 256.f) - mean * mean, 0.f), rstd = 1.f / sqrtf(var + LN_EPS);
#pragma unroll
    for (int dt = 0; dt < 2; ++dt)
#pragma unroll
        for (int g = 0; g < 4; ++g) { const int dv = 64 * wv + 32 * dt + 8 * g + 4 * hi; const f32x4 gg = *(const f32x4*)(ng + hd * 256 + dv);
            const v2u og = *(const v2u*)(Z5 + (size_t)q_abs * 1024 + hd * 256 + dv);
            v2u w; w.x = cvtpk((o[dt][4 * g] - mean) * rstd * gg.x * sigmoid_f(bflo(og.x)), (o[dt][4 * g + 1] - mean) * rstd * gg.y * sigmoid_f(bfhi(og.x)));
            w.y = cvtpk((o[dt][4 * g + 2] - mean) * rstd * gg.z * sigmoid_f(bflo(og.y)), (o[dt][4 * g + 3] - mean) * rstd * gg.w * sigmoid_f(bfhi(og.y)));
            *(v2u*)(Y + (size_t)q_abs * DM + 1024 + hd * 256 + dv) = w; }
    __syncthreads();
}
}
struct Args { const float* in[16]; float* out; unsigned char* ws; int st_lo, st_hi, li, pad; };
template <class T> __device__ __forceinline__ T* asg(T* p) { return (T*)(GAS T*)p; }
#define CAS __attribute__((address_space(4)))
typedef const volatile CAS Args* KArgs;
__device__ __forceinline__ KArgs kargs() { return (KArgs)__builtin_amdgcn_kernarg_segment_ptr(); }
__global__ void __launch_bounds__(NWAVES * 64, 2) fwd(Args args_unused) {
    extern __shared__ __attribute__((aligned(16))) unsigned char lds_raw[];
    LAS unsigned char* lds = (LAS unsigned char*)lds_raw;
    const int G = gridDim.x;
    for (int u = threadIdx.x; u < (LDS_BYTES - LDSCTL_OFF) / 4; u += NWAVES * 64) ((LAS unsigned*)(lds + LDSCTL_OFF))[u] = 0u;
    __syncthreads();
    int lo, hi;
    { KArgs A = kargs(); lo = A->st_lo; hi = A->st_hi;
      if (hi - lo > 1) (void)xcd_barrier_post((unsigned*)(asg(A->ws) + WS_CTL) + CW_BAR + A->li * XCD_BAR_WORDS, (volatile LAS unsigned*)(lds + MISC_OFF) + 8); }
    int st = 0;
#define TID_FRESH() int tid = threadIdx.x; asm volatile("" : "+v"(tid)); const int lane = tid & 63, wave = __builtin_amdgcn_readfirstlane(tid >> 6); (void)lane; (void)wave
#define STEP_ON() (lo <= st && st < hi)
#define STEP_END() do { if (st + 1 < hi) { KArgs A_ = kargs(); XcdBarrier bar_; bar_.bar = (unsigned*)(asg(A_->ws) + WS_CTL) + CW_BAR + A_->li * XCD_BAR_WORDS; bar_.x = xb_xcc_id(); bar_.st = (volatile LAS unsigned*)(lds + MISC_OFF) + 8; xcd_barrier(bar_); } } while (0)

    if (STEP_ON()) {
#ifndef NO_PRO
        TID_FRESH(); KArgs A = kargs();
        ph_prologue(asg(A->in[1]), asg(A->in[2]), asg(A->in[3]), asg(A->in[6]), asg(A->in[7]), asg(A->in[8]), asg(A->in[13]), asg(A->in[14]), asg(A->in[15]), asg(A->ws), lds, tid, lane, wave, G);
#endif
        STEP_END(); }
    ++st;
    if (STEP_ON()) { TID_FRESH(); KArgs A = kargs(); const float* mod = (const float*)(asg(A->ws) + WS_MOD); ph_modulate(asg(A->in[0]), mod, mod + DM, (bf16*)(asg(A->ws) + WS_HB), lane, wave, G); STEP_END(); }
    ++st;

    for (int sl = 0; sl < 6; ++sl) {
        const int l = sl / 3, sub = sl - 3 * l;
        if (sub != 1) {
            if (STEP_ON()) {
                KArgs A = kargs(); unsigned char* ws = asg(A->ws);
                pg8::Gemm g{(const bf16*)(ws + WS_HB), (const bf16*)(ws + WS_W1T) + (size_t)(l * 2 + (sub >> 1)) * N1 * DM, S_, N1, DM}; pg8::StaticOrder SO; SO.init(S_, N1, G, (int)blockIdx.x);
                pg8::EpiSwiGLU E{(bf16*)(ws + WS_BIG), DFF};
#ifndef NO_G1
                pg8::gemm_phase<pg8::EpiSwiGLU, pg8::StaticOrder, true, true>(lds + RING_OFF, g, SO, E);
#endif
                STEP_END();
            }
            ++st;
        } else {
            if (STEP_ON()) {
                KArgs A = kargs(); unsigned char* ws = asg(A->ws);
                pg8::Gemm g{(const bf16*)(ws + WS_HB), (const bf16*)(ws + WS_WINT) + (size_t)l * NZ * DM, S_, NZ, DM}; pg8::StaticOrder SO; SO.init(S_, NZ, G, (int)blockIdx.x);
                pg8::EpiSplit E{(bf16*)(ws + WS_BIG), 1024, 1024, ZT, QSCALE_L2E};
#ifndef NO_GZ
                pg8::gemm_phase<pg8::EpiSplit, pg8::StaticOrder, true, true>(lds + RING_OFF, g, SO, E);
#endif
                STEP_END();
            }
            ++st;
            if (STEP_ON()) {
#ifndef NO_MIX
                TID_FRESH(); KArgs A = kargs(); unsigned char* ws = asg(A->ws);
#ifndef NO_SBA
                sba::phase((const bf16*)(ws + WS_BIG), asg(A->in[12]) + (size_t)l * DM, (bf16*)(ws + WS_YCAT), lds, tid, G);
#endif
#ifndef NO_MLA
                for (int it = blockIdx.x; it < 4 * mls::NSPAN; it += G)
                    mls::phaseA_item(it >> 6, it & 63, (const bf16*)(ws + WS_BIG) + 3 * ZT, (const bf16*)(ws + WS_BIG) + 4 * ZT, asg(A->in[9]) + (size_t)l * 4 * 1024, asg(A->in[10]) + (size_t)l * 1024,
                                     (const float*)(ws + WS_GATES), asg(A->in[11]) + l * 8, (bf16*)(ws + WS_QKT), (float*)(ws + WS_BL), (float*)(ws + WS_LI), (float*)(ws + WS_BTOT), (float*)(ws + WS_DC), (float*)(ws + WS_DN), lds, tid);
#endif
#endif
                STEP_END();
            }
            ++st;
            if (STEP_ON()) {
#ifndef NO_MIX
                TID_FRESH(); KArgs A = kargs(); unsigned char* ws = asg(A->ws);
                mls::phaseS((const float*)(ws + WS_BTOT), (const float*)(ws + WS_DC), (const float*)(ws + WS_DN), (bf16*)(ws + WS_CS), (float*)(ws + WS_NSS), tid, G);
#endif
                STEP_END();
            }
            ++st;
            if (STEP_ON()) {
#ifndef NO_MIX
                TID_FRESH(); KArgs A = kargs(); unsigned char* ws = asg(A->ws);
#ifndef NO_MLD
                for (int it = blockIdx.x; it < 4 * mls::NSPAN * 4; it += G) { const int k = it / (mls::NSPAN * 4), b = it % (mls::NSPAN * 4);
                    mls::phaseD_item(k, b >> 2, (b + k) & 3, (const bf16*)(ws + WS_QKT), (const bf16*)(ws + WS_BIG) + 4 * ZT, (const bf16*)(ws + WS_BIG) + 5 * ZT, (const float*)(ws + WS_BL), (const float*)(ws + WS_LI),
                                     (const bf16*)(ws + WS_CS), (const float*)(ws + WS_NSS), asg(A->in[12]) + (size_t)l * DM + 1024, (bf16*)(ws + WS_YCAT), lds, tid); }
#endif
#endif
                STEP_END();
            }
            ++st;
        }
        if (STEP_ON()) {
            KArgs A = kargs(); unsigned char* ws = asg(A->ws); float* X = (float*)(ws + WS_X);
            pg8::Gemm g; float wgt;
            if (sub != 1) { g = pg8::Gemm{(const bf16*)(ws + WS_BIG), (const bf16*)(ws + WS_W2T) + (size_t)(l * 2 + (sub >> 1)) * DM * DFF, S_, DM, DFF}; wgt = 0.5f; }
            else { g = pg8::Gemm{(const bf16*)(ws + WS_YCAT), (const bf16*)(ws + WS_WOUTT) + (size_t)l * DM * DM, S_, DM, DM}; wgt = 1.0f; }
            pg8::StaticOrder SO; SO.init(S_, DM, G, (int)blockIdx.x);
            pg8::EpiResid E{sl == 0 ? asg(A->in[0]) : X, X, DM, (const float*)(ws + WS_MOD) + l * NMOD + sub * 3 * DM + 2 * DM, wgt, ALPHA};
#ifndef NO_GR
            pg8::gemm_phase<pg8::EpiResid, pg8::StaticOrder, true, true>(lds + RING_OFF, g, SO, E);
#endif
            STEP_END();
        }
        ++st;
        if (STEP_ON()) {
#ifndef NO_LN
            TID_FRESH(); KArgs A = kargs(); unsigned char* ws = asg(A->ws); float* X = (float*)(ws + WS_X);
            const int ln_i = l * 3 + sub; const bool last = (sl == 5);
            const int l2 = (sl + 1) / 3, sub2 = (sl + 1) - 3 * l2; const float* modn = (const float*)(ws + WS_MOD) + l2 * NMOD + sub2 * 3 * DM;
            ph_ln(X, last ? asg(A->out) : X, asg(A->in[4]) + (size_t)ln_i * DM, asg(A->in[5]) + (size_t)ln_i * DM, last ? nullptr : modn, last ? nullptr : modn + DM, (bf16*)(ws + WS_HB),
                  (!last && sub2 == 1) ? (const float*)(ws + WS_WG) + (size_t)l2 * 8 * DM : nullptr, (float*)(ws + WS_GATES), lds, tid, lane, wave, G);
#endif
            STEP_END();
        }
        ++st;
    }
#undef STEP_ON
#undef STEP_END
}

extern "C" void kernel_launch(void* const* d_in, const int* in_sizes, int n_in, void* d_out, int out_size, void* d_ws, size_t ws_size, hipStream_t stream) {
    static int grid = 0;
    if (grid == 0) {
        if (n_in != 16 || in_sizes[0] != S_ * DM || out_size != S_ * DM || ws_size < WS_END) { fprintf(stderr, "kernel_launch: shape mismatch (n_in %d in0 %d out %d ws %zu)\n", n_in, n_in > 0 ? in_sizes[0] : -1, out_size, ws_size); grid = -1; return; }
        int dev = 0, cus = 0, per_cu = 0;
        if (hipGetDevice(&dev) != hipSuccess || hipDeviceGetAttribute(&cus, hipDeviceAttributeMultiprocessorCount, dev) != hipSuccess) { grid = -1; return; }
        if (hipFuncSetAttribute((const void*)fwd, hipFuncAttributeMaxDynamicSharedMemorySize, LDS_BYTES) != hipSuccess) { fprintf(stderr, "kernel_launch: hipFuncSetAttribute failed\n"); grid = -1; return; }
        if (hipOccupancyMaxActiveBlocksPerMultiprocessor(&per_cu, (const void*)fwd, NWAVES * 64, LDS_BYTES) != hipSuccess || per_cu < 1) fprintf(stderr, "kernel_launch: occupancy query reports %d\n", per_cu);
        (void)hipGetLastError();
        grid = cus;
    }
    if (grid < 0) return;
    if (hipMemsetAsync((char*)d_ws + WS_CTL, 0, CTL_ZERO_BYTES, stream) != hipSuccess) { fprintf(stderr, "kernel_launch: memset failed\n"); return; }
    Args a{};
    for (int i = 0; i < 16; ++i) a.in[i] = (const float*)d_in[i];
    a.out = (float*)d_out; a.ws = (unsigned char*)d_ws;
#if MK_ONE_LAUNCH
    a.st_lo = 0; a.st_hi = N_STEPS; a.li = 0;
    hipLaunchKernelGGL(fwd, dim3(grid), dim3(NWAVES * 64), LDS_BYTES, stream, a);
#else
    for (int s = 0; s < N_STEPS; ++s) { a.st_lo = s; a.st_hi = s + 1; a.li = 0; hipLaunchKernelGGL(fwd, dim3(grid), dim3(NWAVES * 64), LDS_BYTES, stream, a); }
#endif
    const hipError_t le = hipPeekAtLastError();
    if (le != hipSuccess) fprintf(stderr, "kernel_launch: launch failed: %s\n", hipGetErrorName(le));
}
```
